# Optimizing an MI355X kernel written in HIP

```python
import math
import jax, jax.numpy as jnp
from jax import lax
import numpy as np

D_MODEL = 1024
BATCH = 8
SEQ = 4096
DEPTH = 2

D_MIX = D_MODEL
GLA_HEADS = 4
GLA_DV = 64
GLA_DK = GLA_DV // 2
GLA_GATE_RANK = 16
GLA_TAU = 16.0
GLA_CHUNK = 64
CONV_CH = D_MIX // 4
CONV_WIDTH = 31
SWA_Q_HEADS = 8
SWA_KV_HEADS = 2
SWA_HEAD_DIM = 64
SWA_WINDOW = 128
SWA_BLOCK = 128
D_FF = 2816
RMS_EPS = 1e-6
LN_EPS = 1e-5

kernel_name = "hybrid_gla_conformer_swa_macaron"


def _in_proj_widths():
    return [
        GLA_HEADS * GLA_DK,
        GLA_HEADS * GLA_DK,
        GLA_HEADS * GLA_DV,
        GLA_HEADS * GLA_DV,
        GLA_GATE_RANK,
        CONV_CH,
        CONV_CH,
        SWA_Q_HEADS * SWA_HEAD_DIM,
        SWA_KV_HEADS * SWA_HEAD_DIM,
        SWA_KV_HEADS * SWA_HEAD_DIM,
    ]


def rmsnorm(x, g):
    x32 = x.astype(jnp.float32)
    y = x32 * lax.rsqrt(jnp.mean(x32 * x32, axis=-1, keepdims=True) + RMS_EPS)
    return (y * g.astype(jnp.float32)).astype(x.dtype)


def swiglu_ffn(h, w_gate, w_up, w_down):
    return (jax.nn.silu(h @ w_gate) * (h @ w_up)) @ w_down


def gla_group(q, k, v, glog, r, norm_g):
    B, S, H, DK = q.shape
    DV = v.shape[-1]
    C = GLA_CHUNK
    N = S // C
    f32 = jnp.float32

    def chunks(t):
        return t.astype(f32).reshape(B, N, C, H, t.shape[-1]).transpose(1, 0, 3, 2, 4)

    qc = chunks(q) * (DK ** -0.5)
    kc = chunks(k)
    vc = chunks(v)
    bc = jnp.cumsum(chunks(glog), axis=3)
    causal = jnp.tril(jnp.ones((C, C), dtype=bool))[:, :, None]

    def step(state, inp):
        qn, kn, vn, bn = inp
        diff = bn[:, :, :, None, :] - bn[:, :, None, :, :]
        decay = jnp.where(causal, jnp.exp(jnp.where(causal, diff, 0.0)), 0.0)
        attn = jnp.einsum('bhid,bhjd,bhijd->bhij', qn, kn, decay)
        o = jnp.einsum('bhij,bhjv->bhiv', attn, vn) \
            + jnp.einsum('bhid,bhdv->bhiv', qn * jnp.exp(bn), state)
        b_last = bn[:, :, -1:, :]
        state = jnp.exp(b_last[:, :, 0, :])[..., None] * state \
            + jnp.einsum('bhjd,bhjv->bhdv', kn * jnp.exp(b_last - bn), vn)
        return state, o

    s0 = jnp.zeros((B, H, DK, DV), f32)
    _, o = lax.scan(step, s0, (qc, kc, vc, bc))
    o = o.transpose(1, 0, 3, 2, 4).reshape(B, S, H, DV)
    o = o * lax.rsqrt(jnp.mean(o * o, axis=-1, keepdims=True) + RMS_EPS) * norm_g.astype(f32)
    o = o.reshape(B, S, H * DV) * jax.nn.silu(r.astype(f32))
    return o.astype(q.dtype)


def conv_group(a, g, conv_w, conv_b, ln_g, ln_b):
    u = a * jax.nn.sigmoid(g)
    y = lax.conv_general_dilated(
        u, conv_w[:, None, :].astype(u.dtype), window_strides=(1,),
        padding=[(CONV_WIDTH - 1, 0)], dimension_numbers=('NWC', 'WIO', 'NWC'),
        feature_group_count=CONV_CH) + conv_b
    y32 = y.astype(jnp.float32)
    mu = jnp.mean(y32, axis=-1, keepdims=True)
    var = jnp.mean(jnp.square(y32 - mu), axis=-1, keepdims=True)
    y32 = (y32 - mu) * lax.rsqrt(var + LN_EPS) * ln_g.astype(jnp.float32) + ln_b.astype(jnp.float32)
    return jax.nn.silu(y32).astype(a.dtype)


def swa_group(q, k, v, sinks):
    B, S, _ = q.shape
    BLK, HKV, DH = SWA_BLOCK, SWA_KV_HEADS, SWA_HEAD_DIM
    G = SWA_Q_HEADS // HKV
    nb = S // BLK
    qb = q.reshape(B, nb, BLK, HKV, G, DH)
    kb = k.reshape(B, nb, BLK, HKV, DH)
    vb = v.reshape(B, nb, BLK, HKV, DH)

    def with_prev(t):
        prev = jnp.pad(t, ((0, 0), (1, 0), (0, 0), (0, 0), (0, 0)))[:, :-1]
        return jnp.concatenate([prev, t], axis=2)

    kk, vv = with_prev(kb), with_prev(vb)
    s = jnp.einsum('bnqhgd,bnkhd->bnhgqk', qb, kk).astype(jnp.float32) * (DH ** -0.5)
    qi = jnp.arange(BLK)[:, None]
    kj = jnp.arange(2 * BLK)[None, :]
    dist = qi - kj + BLK
    blk = jnp.arange(nb)[:, None, None]
    valid = (dist >= 0) & (dist < SWA_WINDOW) & ((blk > 0) | (kj >= BLK))
    slopes = jnp.exp2(-8.0 * (jnp.arange(SWA_Q_HEADS, dtype=jnp.float32) + 1.0) / SWA_Q_HEADS)
    slopes = slopes.reshape(HKV, G)
    s = s - slopes[:, :, None, None] * dist.astype(jnp.float32)
    s = jnp.where(valid[None, :, None, None], s, -jnp.inf)
    sink = jnp.broadcast_to(sinks.astype(jnp.float32).reshape(HKV, G)[None, None, :, :, None, None],
                            s.shape[:-1] + (1,))
    p = jax.nn.softmax(jnp.concatenate([s, sink], axis=-1), axis=-1)[..., :-1]
    o = jnp.einsum('bnhgqk,bnkhd->bnqhgd', p.astype(v.dtype), vv)
    return o.reshape(B, S, SWA_Q_HEADS * DH)


def hybrid_mixer(h, w_in, gla_w_gate2, gla_b_gate, gla_norm_g, conv_w, conv_b,
                 conv_ln_g, conv_ln_b, swa_sinks, w_out):
    B, S, _ = h.shape
    p = h @ w_in
    offsets = np.cumsum(_in_proj_widths())[:-1].tolist()
    gq, gk, gv, gr, glr, ca, cg, sq, sk, sv = jnp.split(p, offsets, axis=-1)
    glog = jax.nn.log_sigmoid((glr @ gla_w_gate2 + gla_b_gate).astype(jnp.float32)) / GLA_TAU
    o_gla = gla_group(gq.reshape(B, S, GLA_HEADS, GLA_DK), gk.reshape(B, S, GLA_HEADS, GLA_DK),
                      gv.reshape(B, S, GLA_HEADS, GLA_DV), glog.reshape(B, S, GLA_HEADS, GLA_DK),
                      gr, gla_norm_g)
    o_conv = conv_group(ca, cg, conv_w, conv_b, conv_ln_g, conv_ln_b)
    o_swa = swa_group(sq, sk, sv, swa_sinks)
    return jnp.concatenate([o_gla, o_conv, o_swa], axis=-1) @ w_out


def setup_inputs(seed: int = 0) -> dict:
    key = jax.random.key(seed)
    ks = jax.random.split(key, 16)
    f32 = jnp.float32
    d_in = sum(_in_proj_widths())
    nrm = lambda k, shape, scale: jax.random.normal(k, shape, f32) * scale
    return {
        "x": jax.random.normal(ks[0], (BATCH, SEQ, D_MODEL), f32),
        "norm_g": 1.0 + nrm(ks[1], (DEPTH, 6, D_MODEL), 0.05),
        "ffn_w_gate": nrm(ks[2], (DEPTH, 2, D_MODEL, D_FF), D_MODEL ** -0.5),
        "ffn_w_up": nrm(ks[3], (DEPTH, 2, D_MODEL, D_FF), D_MODEL ** -0.5),
        "ffn_w_down": nrm(ks[4], (DEPTH, 2, D_FF, D_MODEL), D_FF ** -0.5),
        "w_in": nrm(ks[5], (DEPTH, D_MODEL, d_in), D_MODEL ** -0.5),
        "gla_w_gate2": nrm(ks[6], (DEPTH, GLA_GATE_RANK, GLA_HEADS * GLA_DK), GLA_GATE_RANK ** -0.5),
        "gla_b_gate": nrm(ks[7], (DEPTH, GLA_HEADS * GLA_DK), 0.1),
        "gla_norm_g": 1.0 + nrm(ks[8], (DEPTH, GLA_HEADS, GLA_DV), 0.05),
        "conv_w": nrm(ks[9], (DEPTH, CONV_WIDTH, CONV_CH), CONV_WIDTH ** -0.5),
        "conv_b": nrm(ks[10], (DEPTH, CONV_CH), 0.02),
        "conv_ln_g": 1.0 + nrm(ks[11], (DEPTH, CONV_CH), 0.05),
        "conv_ln_b": nrm(ks[12], (DEPTH, CONV_CH), 0.02),
        "swa_sinks": nrm(ks[13], (DEPTH, SWA_Q_HEADS), 0.5),
        "w_out": nrm(ks[14], (DEPTH, D_MIX, D_MODEL), D_MIX ** -0.5),
    }


def reference(x, norm_g, ffn_w_gate, ffn_w_up, ffn_w_down, w_in, gla_w_gate2, gla_b_gate,
              gla_norm_g, conv_w, conv_b, conv_ln_g, conv_ln_b, swa_sinks, w_out):
    for l in range(DEPTH):
        g = norm_g[l]
        h = swiglu_ffn(rmsnorm(x, g[0]), ffn_w_gate[l, 0], ffn_w_up[l, 0], ffn_w_down[l, 0])
        x = x + 0.5 * rmsnorm(h, g[1])
        h = hybrid_mixer(rmsnorm(x, g[2]), w_in[l], gla_w_gate2[l], gla_b_gate[l], gla_norm_g[l],
                         conv_w[l], conv_b[l], conv_ln_g[l], conv_ln_b[l], swa_sinks[l], w_out[l])
        x = x + rmsnorm(h, g[3])
        h = swiglu_ffn(rmsnorm(x, g[4]), ffn_w_gate[l, 1], ffn_w_up[l, 1], ffn_w_down[l, 1])
        x = x + 0.5 * rmsnorm(h, g[5])
    return x
```

```cpp
#ifndef HOST_EMU
#include <hip/hip_runtime.h>
#include <cstdio>
#include <cstdint>
#define DEV __device__ __forceinline__
#define LAS __attribute__((address_space(3)))
#define GAS __attribute__((address_space(1)))
#endif

#ifndef CFG_BATCH
#define CFG_BATCH 8
#endif
#ifndef CFG_SEQ
#define CFG_SEQ 4096
#endif
constexpr int NBATCH = CFG_BATCH, SEQ = CFG_SEQ, M = NBATCH * SEQ;
constexpr int DM = 1024, DFF = 2816, DIN = 2064, NGU = 2 * DFF, DEPTH = 2;
constexpr int NP = 2304;
constexpr int PC_GQ = 0, PC_GK = 128, PC_GV = 256, PC_GR = 512, PC_CA = 768, PC_CG = 1024, PC_SQ = 1280, PC_SK = 1792, PC_SV = 1920, PC_GLR = 2048;
constexpr int CC_GLA = 0, CC_CONV = 256, CC_SWA = 512;
constexpr int NCH = SEQ / 64;
constexpr int NBLK = SEQ / 128;
constexpr float RMS_EPS = 1e-6f, LN_EPS = 1e-5f;
static_assert(M % 256 == 0 && SEQ % 512 == 0, "shape");

typedef unsigned short bf16_t;
typedef short bf16x8 __attribute__((ext_vector_type(8)));
typedef short s16x4 __attribute__((ext_vector_type(4)));
typedef float f32x4 __attribute__((ext_vector_type(4)));
typedef float f32x16 __attribute__((ext_vector_type(16)));
typedef unsigned u32x4 __attribute__((ext_vector_type(4)));
typedef unsigned u32x2 __attribute__((ext_vector_type(2)));

#ifndef HOST_EMU
DEV f32x16 mfma32(bf16x8 a, bf16x8 b, f32x16 c) { return __builtin_amdgcn_mfma_f32_32x32x16_bf16(a, b, c, 0, 0, 0); }
DEV float shfl_xor_f(float v, int m) { return __shfl_xor(v, m); }
DEV float shfl_f(float v, int src) { return __shfl(v, src); }
DEV void wg_sync() { __syncthreads(); }
DEV void wave_sync() { asm volatile("s_waitcnt lgkmcnt(0)" ::: "memory"); }
typedef float f32x2_t __attribute__((ext_vector_type(2)));
typedef __bf16 bf16x2_t __attribute__((ext_vector_type(2)));
DEV unsigned pk2(float lo, float hi) { const f32x2_t v = {lo, hi}; const bf16x2_t b = __builtin_convertvector(v, bf16x2_t); return __builtin_bit_cast(unsigned, b); }
DEV float fexp2(float x) { return __builtin_amdgcn_exp2f(x); }
DEV float flog2(float x) { return __builtin_amdgcn_logf(x); }
DEV float frcp(float x) { return __builtin_amdgcn_rcpf(x); }
DEV float frsq(float x) { return __builtin_amdgcn_rsqf(x); }
template <class T> DEV T ldg(const void* p) { return *(const GAS T*)p; }
template <class T> DEV void stg(void* p, T v) { *(GAS T*)p = v; }
template <class T> DEV T lds_ld(LAS unsigned char* p) { return *(LAS T*)p; }
template <class T> DEV void lds_st(LAS unsigned char* p, T v) { *(LAS T*)p = v; }
#endif
DEV float bf2f(unsigned short b) { return __builtin_bit_cast(float, (unsigned)b << 16); }
DEV float bflo(unsigned w) { return __builtin_bit_cast(float, w << 16); }
DEV float bfhi(unsigned w) { return __builtin_bit_cast(float, w & 0xffff0000u); }
DEV float fexp(float x) { return fexp2(x * 1.4426950408889634f); }
DEV float fsigmoid(float x) { return frcp(1.0f + fexp(-x)); }
DEV float wave_sum(float v) {
#pragma unroll
    for (int o = 1; o < 64; o <<= 1) v += shfl_xor_f(v, o);
    return v;
}
DEV int crow(int reg, int h) { return (reg & 3) + 8 * (reg >> 2) + 4 * h; }
DEV bf16x8 pack8(const f32x16& x, int s) {
    u32x4 p; p.x = pk2(x[8 * s], x[8 * s + 1]); p.y = pk2(x[8 * s + 2], x[8 * s + 3]); p.z = pk2(x[8 * s + 4], x[8 * s + 5]); p.w = pk2(x[8 * s + 6], x[8 * s + 7]);
    return __builtin_bit_cast(bf16x8, p);
}
DEV f32x16 zero16() { f32x16 z; for (int i = 0; i < 16; ++i) z[i] = 0.f; return z; }

struct Ctx { LAS unsigned char* lds; int tid, lane, wave, bid, G; };

DEV int rowmap(int mode, int n) {
    if (mode == 0) return n;
    if (mode == 1) return ((n >> 7) << 8) + (n & 127);
    if (mode == 2) return ((n >> 7) << 8) + 128 + (n & 127);
    return n < 768 ? n : (n < 784 ? 2048 + (n - 768) : n - 16);
}
DEV void transpose_item(const float* W, int K, int N, int k0, int n0, bf16_t* WT, int mode, const float* gain, LAS unsigned char* scrb, int lane) {
    const int cl = lane & 31, col = n0 + cl;
#pragma unroll 8
    for (int i = 0; i < 32; ++i) { const int kk = 2 * i + (lane >> 5); float v = col < N ? ldg<float>(W + (size_t)(k0 + kk) * N + col) : 0.f; if (gain) v *= ldg<float>(gain + k0 + kk);
        lds_st<float>(scrb + (kk * 33 + cl) * 4, v); }
    wave_sync();
    const int c8 = lane & 7;
#pragma unroll
    for (int j = 0; j < 4; ++j) { const int n = (lane >> 3) + 8 * j; LAS unsigned char* s = scrb + ((8 * c8) * 33 + n) * 4;
        u32x4 o; o.x = pk2(lds_ld<float>(s), lds_ld<float>(s + 132)); o.y = pk2(lds_ld<float>(s + 264), lds_ld<float>(s + 396));
        o.z = pk2(lds_ld<float>(s + 528), lds_ld<float>(s + 660)); o.w = pk2(lds_ld<float>(s + 792), lds_ld<float>(s + 924));
        if (n0 + n < N) stg<u32x4>(WT + (size_t)rowmap(mode, n0 + n) * K + k0 + 8 * c8, o); }
    wave_sync();
}
struct Inputs { const float *x, *norm_g, *wg, *wu, *wd, *win, *gw2, *gb, *gng, *cw, *cb, *clg, *clb, *sinks, *wout; };
struct Bufs { bf16_t *Wgu, *Wd, *Win, *Wout, *XN, *H, *ACT, *P, *CAT; float *DS, *DD; float* X; };
constexpr int I_GU = (DM / 64) * (DFF / 32), I_D = (DFF / 64) * (DM / 32), I_IN = (DM / 64) * ((DIN + 31) / 32), I_OUT = (DM / 64) * (DM / 32);
constexpr int NITEMS_W = 8 * I_GU + 4 * I_D + 2 * I_IN + 2 * I_OUT;

DEV void rms_row_to_bf16(const float* xrow, bf16_t* orow, int lane) {
    f32x4 v[4]; float s = 0.f;
#pragma unroll
    for (int j = 0; j < 4; ++j) { v[j] = ldg<f32x4>(xrow + 4 * lane + 256 * j); s += (v[j].x * v[j].x + v[j].y * v[j].y) + (v[j].z * v[j].z + v[j].w * v[j].w); }
    const float r = frsq(wave_sum(s) * (1.f / DM) + RMS_EPS);
#pragma unroll
    for (int j = 0; j < 4; ++j) { u32x2 o; o.x = pk2(v[j].x * r, v[j].y * r); o.y = pk2(v[j].z * r, v[j].w * r); stg<u32x2>(orow + 4 * lane + 256 * j, o); }
}
DEV void prologue_phase(Ctx& c, const Inputs& in, const Bufs& B) {
    LAS unsigned char* scr = c.lds + c.wave * 16384;
    const int gw = c.bid * 8 + c.wave, NGW = c.G * 8;
    for (int it = gw; it < NITEMS_W; it += NGW) {
        int r = it;
        if (r < 8 * I_GU) { const int q = r / I_GU, i = r % I_GU, lf = q >> 1, up = q & 1, l = lf >> 1, f = lf & 1; constexpr int nb = DFF / 32;
            transpose_item((up ? in.wu : in.wg) + (size_t)lf * DM * DFF, DM, DFF, 64 * (i / nb), 32 * (i % nb), B.Wgu + (size_t)lf * NGU * DM, up ? 2 : 1, in.norm_g + (l * 6 + (f ? 4 : 0)) * DM, scr, c.lane); continue; }
        r -= 8 * I_GU;
        if (r < 4 * I_D) { const int lf = r / I_D, i = r % I_D; constexpr int nb = DM / 32;
            transpose_item(in.wd + (size_t)lf * DFF * DM, DFF, DM, 64 * (i / nb), 32 * (i % nb), B.Wd + (size_t)lf * DM * DFF, 0, nullptr, scr, c.lane); continue; }
        r -= 4 * I_D;
        if (r < 2 * I_IN) { const int l = r / I_IN, i = r % I_IN; constexpr int nb = (DIN + 31) / 32;
            transpose_item(in.win + (size_t)l * DM * DIN, DM, DIN, 64 * (i / nb), 32 * (i % nb), B.Win + (size_t)l * NP * DM, 3, in.norm_g + (l * 6 + 2) * DM, scr, c.lane); continue; }
        r -= 2 * I_IN;
        { const int l = r / I_OUT, i = r % I_OUT; constexpr int nb = DM / 32;
            transpose_item(in.wout + (size_t)l * DM * DM, DM, DM, 64 * (i / nb), 32 * (i % nb), B.Wout + (size_t)l * DM * DM, 0, nullptr, scr, c.lane); }
    }
    constexpr int PADV = (NP - DIN) * DM / 8;
    for (int q = c.bid * 512 + c.tid; q < 2 * PADV; q += c.G * 512) { const int l = q / PADV, i = q % PADV; stg<u32x4>(B.Win + (size_t)l * NP * DM + (size_t)DIN * DM + (size_t)i * 8, (u32x4){0u, 0u, 0u, 0u}); }
    for (int m = gw; m < M; m += NGW) rms_row_to_bf16(in.x + (size_t)m * DM, B.XN + (size_t)m * DM, c.lane);
}

DEV void thin_phase(Ctx& c, const bf16_t* H, const float* xin, float* xout, bf16_t* XN, const float* gain, float alpha, bool write_xn) {
    const int gw = c.bid * 8 + c.wave, NGW = c.G * 8, lane = c.lane;
    f32x4 g[4];
#pragma unroll
    for (int j = 0; j < 4; ++j) g[j] = ldg<f32x4>(gain + 4 * lane + 256 * j);
    for (int m = gw; m < M; m += NGW) {
        f32x4 hv[4], xv[4]; float s = 0.f;
#pragma unroll
        for (int j = 0; j < 4; ++j) { const u32x2 w = ldg<u32x2>(H + (size_t)m * DM + 4 * lane + 256 * j); xv[j] = ldg<f32x4>(xin + (size_t)m * DM + 4 * lane + 256 * j);
            hv[j] = (f32x4){bflo(w.x), bfhi(w.x), bflo(w.y), bfhi(w.y)}; s += (hv[j].x * hv[j].x + hv[j].y * hv[j].y) + (hv[j].z * hv[j].z + hv[j].w * hv[j].w); }
        const float rs = frsq(wave_sum(s) * (1.f / DM) + RMS_EPS) * alpha; float s2 = 0.f;
#pragma unroll
        for (int j = 0; j < 4; ++j) { xv[j] = xv[j] + hv[j] * g[j] * rs; stg<f32x4>(xout + (size_t)m * DM + 4 * lane + 256 * j, xv[j]);
            s2 += (xv[j].x * xv[j].x + xv[j].y * xv[j].y) + (xv[j].z * xv[j].z + xv[j].w * xv[j].w); }
        if (write_xn) { const float r2 = frsq(wave_sum(s2) * (1.f / DM) + RMS_EPS);
#pragma unroll
            for (int j = 0; j < 4; ++j) { u32x2 o; o.x = pk2(xv[j].x * r2, xv[j].y * r2); o.y = pk2(xv[j].z * r2, xv[j].w * r2); stg<u32x2>(XN + (size_t)m * DM + 4 * lane + 256 * j, o); } }
    }
}

constexpr int CV_T = 64, CV_U = 0, CV_Y = 49152;
DEV void conv_item(Ctx& c, int item, const bf16_t* P, bf16_t* CAT, const float* cw, const float* cb, const float* lng, const float* lnb) {
    const int t0 = item * CV_T, s0 = t0 % SEQ, tid = c.tid;
    for (int q = tid; q < 94 * 32; q += 512) { const int r = q >> 5, c8 = q & 31; u32x4 o = (u32x4){0u, 0u, 0u, 0u};
        if (s0 - 30 + r >= 0) { const size_t row = (size_t)(t0 - 30 + r) * NP; const u32x4 a = ldg<u32x4>(P + row + PC_CA + 8 * c8), g = ldg<u32x4>(P + row + PC_CG + 8 * c8);
#pragma unroll
            for (int e = 0; e < 4; ++e) o[e] = pk2(bflo(a[e]) * fsigmoid(bflo(g[e])), bfhi(a[e]) * fsigmoid(bfhi(g[e]))); }
        lds_st<u32x4>(c.lds + CV_U + r * 512 + c8 * 16, o); }
    wg_sync();
    { const int ch = tid & 255, half = tid >> 8; float w[31];
#pragma unroll
        for (int j = 0; j < 31; ++j) w[j] = ldg<float>(cw + j * 256 + ch);
        const float bias = ldg<float>(cb + ch);
#pragma unroll 1
        for (int sub = 0; sub < 2; ++sub) { const int tb = 32 * half + 16 * sub; float acc[16];
#pragma unroll
            for (int i = 0; i < 16; ++i) acc[i] = bias;
#pragma unroll
            for (int r = 0; r < 46; ++r) { const float u = bf2f(lds_ld<unsigned short>(c.lds + CV_U + (tb + r) * 512 + ch * 2));
#pragma unroll
                for (int i = 0; i < 16; ++i) { const int j = r - i; if (j >= 0 && j < 31) acc[i] += w[j] * u; } }
#pragma unroll
            for (int i = 0; i < 16; ++i) lds_st<float>(c.lds + CV_Y + ((tb + i) * 256 + ch) * 4, acc[i]); } }
    wg_sync();
    { const int lane = c.lane; const f32x4 lg = ldg<f32x4>(lng + 4 * lane), lb = ldg<f32x4>(lnb + 4 * lane);
#pragma unroll 2
        for (int i = 0; i < 8; ++i) { const int t = c.wave * 8 + i; const f32x4 y = lds_ld<f32x4>(c.lds + CV_Y + (t * 256 + 4 * lane) * 4);
            const float mean = wave_sum((y.x + y.y) + (y.z + y.w)) * (1.f / 256.f); const f32x4 d = y - mean;
            const float var = wave_sum((d.x * d.x + d.y * d.y) + (d.z * d.z + d.w * d.w)) * (1.f / 256.f); const float rstd = frsq(var + LN_EPS);
            f32x4 z = d * rstd * lg + lb; z.x *= fsigmoid(z.x); z.y *= fsigmoid(z.y); z.z *= fsigmoid(z.z); z.w *= fsigmoid(z.w);
            u32x2 o; o.x = pk2(z.x, z.y); o.y = pk2(z.z, z.w); stg<u32x2>(CAT + (size_t)(t0 + t) * DM + CC_CONV + 4 * lane, o); } }
    wg_sync();
}

constexpr int SW_K = 0, SW_KS = 144, SW_V = 256 * SW_KS, SW_VS = 520;
DEV void swa_item(Ctx& c, int item, const bf16_t* P, bf16_t* CAT, const float* sinks) {
    const int n = item % NBLK, kvh = (item / NBLK) & 1, b = item / (2 * NBLK), tid = c.tid, lane = c.lane;
    const long rowK0 = (long)b * SEQ + 128 * (n - 1);
    for (int q = tid; q < 2048; q += 512) { const int j = q >> 3, part = q & 7; u32x4 v = (u32x4){0u, 0u, 0u, 0u};
        if (n > 0 || j >= 128) v = ldg<u32x4>(P + (size_t)(rowK0 + j) * NP + PC_SK + 64 * kvh + 8 * part);
        lds_st<u32x4>(c.lds + SW_K + j * SW_KS + part * 16, v); }
    { const int j = tid & 255, dh = tid >> 8; const bool ok = (n > 0 || j >= 128);
#pragma unroll
        for (int q = 0; q < 4; ++q) { u32x4 v = (u32x4){0u, 0u, 0u, 0u}; if (ok) v = ldg<u32x4>(P + (size_t)(rowK0 + j) * NP + PC_SV + 64 * kvh + 32 * dh + 8 * q);
#pragma unroll
            for (int e = 0; e < 4; ++e) { const int d = 32 * dh + 8 * q + 2 * e;
                lds_st<unsigned short>(c.lds + SW_V + d * SW_VS + j * 2, (unsigned short)(v[e] & 0xffffu)); lds_st<unsigned short>(c.lds + SW_V + (d + 1) * SW_VS + j * 2, (unsigned short)(v[e] >> 16)); } } }
    wg_sync();
    const int hq = 4 * kvh + (c.wave >> 1), qh = c.wave & 1, il = lane & 31, h = lane >> 5;
    const float L2E = 1.4426950408889634f;
    const float slope2 = fexp2(-(float)(hq + 1)) * L2E, sink2 = ldg<float>(sinks + hq) * L2E, sc2 = 0.125f * L2E;
#pragma unroll 1
    for (int tq = 0; tq < 2; ++tq) {
        const int q0 = 64 * qh + 32 * tq, kt0 = q0 >> 5; const size_t qrow = (size_t)b * SEQ + 128 * n + q0 + il;
        bf16x8 Qf[4];
#pragma unroll
        for (int ks = 0; ks < 4; ++ks) Qf[ks] = ldg<bf16x8>(P + qrow * NP + PC_SQ + 64 * hq + 16 * ks + 8 * h);
        f32x16 S[5];
#pragma unroll
        for (int t = 0; t < 5; ++t) { f32x16 acc = zero16();
#pragma unroll
            for (int ks = 0; ks < 4; ++ks) { const bf16x8 A = lds_ld<bf16x8>(c.lds + SW_K + (32 * (kt0 + t) + il) * SW_KS + (16 * ks + 8 * h) * 2); acc = mfma32(A, Qf[ks], acc); }
            S[t] = acc; }
        float mx = sink2; const int iq = q0 + il;
#pragma unroll
        for (int t = 0; t < 5; ++t)
#pragma unroll
            for (int e = 0; e < 16; ++e) { const int j = 32 * (kt0 + t) + crow(e, h), dist = iq - j + 128; const bool ok = dist >= 0 && dist < 128 && (n > 0 || j >= 128);
                const float v = ok ? S[t][e] * sc2 - slope2 * (float)dist : -1e30f; S[t][e] = v; mx = fmaxf(mx, v); }
        mx = fmaxf(mx, shfl_xor_f(mx, 32)); float sum = 0.f;
#pragma unroll
        for (int t = 0; t < 5; ++t)
#pragma unroll
            for (int e = 0; e < 16; ++e) { const float p = fexp2(S[t][e] - mx); S[t][e] = p; sum += p; }
        sum += shfl_xor_f(sum, 32); sum += fexp2(sink2 - mx); const float inv = frcp(sum);
        f32x16 O[2]; O[0] = zero16(); O[1] = zero16();
#pragma unroll
        for (int t = 0; t < 5; ++t)
#pragma unroll
            for (int s = 0; s < 2; ++s) { const bf16x8 Pf = pack8(S[t], s);
#pragma unroll
                for (int V = 0; V < 2; ++V) { LAS unsigned char* vp = c.lds + SW_V + (32 * V + il) * SW_VS + (32 * (kt0 + t) + 16 * s + 4 * h) * 2;
                    const s16x4 lo = lds_ld<s16x4>(vp), hi = lds_ld<s16x4>(vp + 16); const bf16x8 A = __builtin_shufflevector(lo, hi, 0, 1, 2, 3, 4, 5, 6, 7);
                    O[V] = mfma32(A, Pf, O[V]); } }
#pragma unroll
        for (int V = 0; V < 2; ++V)
#pragma unroll
            for (int g = 0; g < 4; ++g) { u32x2 o; o.x = pk2(O[V][4 * g] * inv, O[V][4 * g + 1] * inv); o.y = pk2(O[V][4 * g + 2] * inv, O[V][4 * g + 3] * inv);
                stg<u32x2>(CAT + qrow * DM + CC_SWA + 64 * hq + 32 * V + 8 * g + 4 * h, o); }
    }
    wg_sync();
}

constexpr int GL_VS = 136, GL_VT = 64 * GL_VS  , GL_SG = 8 * GL_VT, GL_SS = 72, GL_SGW = 64 * GL_SS  ;
DEV void gla_stage_vt(LAS unsigned char* vt, const bf16_t* P, size_t row0, int head, int lane) {
#pragma unroll
    for (int q = 0; q < 8; ++q) { const u32x4 v = ldg<u32x4>(P + (row0 + lane) * NP + PC_GV + 64 * head + 8 * q);
#pragma unroll
        for (int e = 0; e < 4; ++e) { const int d = 8 * q + 2 * e; lds_st<unsigned short>(vt + d * GL_VS + lane * 2, (unsigned short)(v[e] & 0xffffu)); lds_st<unsigned short>(vt + (d + 1) * GL_VS + lane * 2, (unsigned short)(v[e] >> 16)); } }
    wave_sync();
}
DEV bf16x8 gla_vfrag(LAS unsigned char* vt, int V, int T, int s, int lane) {
    LAS unsigned char* p = vt + (32 * V + (lane & 31)) * GL_VS + (32 * T + 16 * s + 4 * (lane >> 5)) * 2;
    const s16x4 lo = lds_ld<s16x4>(p), hi = lds_ld<s16x4>(p + 16); return __builtin_shufflevector(lo, hi, 0, 1, 2, 3, 4, 5, 6, 7);
}
DEV void gla_gate(const bf16_t* P, size_t row0, int head, const float* w2, const float* gb, int lane, bf16x8 (&ghi)[2][2], bf16x8 (&glo)[2][2]) {
    const int cl = lane & 31, h = lane >> 5;
    u32x4 wb;
#pragma unroll
    for (int e = 0; e < 4; ++e) wb[e] = pk2(ldg<float>(w2 + (8 * h + 2 * e) * 128 + 32 * head + cl), ldg<float>(w2 + (8 * h + 2 * e + 1) * 128 + 32 * head + cl));
    const bf16x8 Bw = __builtin_bit_cast(bf16x8, wb); const float bias = ldg<float>(gb + 32 * head + cl);
#pragma unroll
    for (int T = 0; T < 2; ++T) { const bf16x8 A = ldg<bf16x8>(P + (row0 + 32 * T + cl) * NP + PC_GLR + 8 * h); f32x16 z = mfma32(A, Bw, zero16()); f32x16 lo;
#pragma unroll
        for (int e = 0; e < 16; ++e) { const float v = z[e] + bias; const float ls = fminf(v, 0.f) - flog2(1.0f + fexp(-fabsf(v))) * 0.6931471805599453f;
            const float g = ls * (1.0f / 16.0f); const float gh = __builtin_bit_cast(float, __builtin_bit_cast(unsigned, g) & 0xffff0000u); z[e] = gh; lo[e] = g - gh; }
#pragma unroll
        for (int s = 0; s < 2; ++s) { ghi[T][s] = pack8(z, s); glo[T][s] = pack8(lo, s); } }
}
DEV bf16x8 tri_frag(int s, int lane) {
    bf16x8 f; const int r = lane & 31, h = lane >> 5;
#pragma unroll
    for (int j = 0; j < 8; ++j) f[j] = (16 * s + 8 * (j >> 2) + 4 * h + (j & 3)) <= r ? (short)0x3F80 : (short)0;
    return f;
}
DEV bf16x8 ones_frag() { bf16x8 f; for (int j = 0; j < 8; ++j) f[j] = (short)0x3F80; return f; }

DEV void gla_m1_chunk(Ctx& c, int ci  , const bf16_t* P, float* DS, float* DD, const float* w2, const float* gb) {
    const int lane = c.lane, cl = lane & 31, h = lane >> 5, n = ci % NCH, head = (ci / NCH) & 3, b = ci / (4 * NCH); const size_t row0 = (size_t)b * SEQ + 64 * n;
    LAS unsigned char* vt = c.lds + c.wave * GL_VT;
    gla_stage_vt(vt, P, row0, head, lane);
    bf16x8 ghi[2][2], glo[2][2]; gla_gate(P, row0, head, w2, gb, lane, ghi, glo);
    f32x16 bt[2]; bt[0] = zero16(); bt[1] = zero16(); const bf16x8 ones = ones_frag();
#pragma unroll
    for (int s = 0; s < 2; ++s) { const bf16x8 tri = tri_frag(s, lane);
        bt[0] = mfma32(tri, ghi[0][s], bt[0]); bt[0] = mfma32(tri, glo[0][s], bt[0]);
        bt[1] = mfma32(ones, ghi[0][s], bt[1]); bt[1] = mfma32(ones, glo[0][s], bt[1]); bt[1] = mfma32(tri, ghi[1][s], bt[1]); bt[1] = mfma32(tri, glo[1][s], bt[1]); }
    const float blast = shfl_f(bt[1][15], 32 + cl);
    bf16x8 kh[2][2];
#pragma unroll
    for (int T = 0; T < 2; ++T) { f32x16 kk;
#pragma unroll
        for (int e = 0; e < 16; ++e) { const float kv = bf2f(ldg<unsigned short>(P + (row0 + 32 * T + crow(e, h)) * NP + PC_GK + 32 * head + cl)); kk[e] = kv * fexp(blast - bt[T][e]); }
        kh[T][0] = pack8(kk, 0); kh[T][1] = pack8(kk, 1); }
#pragma unroll
    for (int V = 0; V < 2; ++V) { f32x16 d = zero16();
#pragma unroll
        for (int T = 0; T < 2; ++T)
#pragma unroll
            for (int s = 0; s < 2; ++s) d = mfma32(kh[T][s], gla_vfrag(vt, V, T, s, lane), d);
#pragma unroll
        for (int e = 0; e < 16; ++e) stg<float>(DS + (size_t)ci * 2048 + crow(e, h) * 64 + 32 * V + cl, d[e]); }
    if (lane < 32) stg<float>(DD + (size_t)ci * 32 + cl, fexp(blast));
    wave_sync();
}
DEV void gla_m2_group(Ctx& c, int gi  , const bf16_t* P, bf16_t* CAT, const float* DS, const float* DD, const float* w2, const float* gb, const float* gng) {
    const int lane = c.lane, cl = lane & 31, h = lane >> 5, g = gi % (NCH / 8), bh = gi / (NCH / 8), head = bh & 3, b = bh >> 2;
    { const int e4 = c.tid * 4, dk = e4 >> 6, dv0 = e4 & 63; f32x4 S = (f32x4){0.f, 0.f, 0.f, 0.f}; const size_t cb = (size_t)bh * NCH;
#pragma unroll 4
        for (int m = 0; m < g * 8; ++m) { const float dd = ldg<float>(DD + (cb + m) * 32 + dk); const f32x4 ds = ldg<f32x4>(DS + (cb + m) * 2048 + e4); S = S * dd + ds; }
#pragma unroll
        for (int w = 0; w < 8; ++w) { LAS unsigned char* sg = c.lds + GL_SG + w * GL_SGW + dk * 2;
            lds_st<unsigned short>(sg + (dv0 + 0) * GL_SS, (unsigned short)(pk2(S.x, 0.f) & 0xffffu)); lds_st<unsigned short>(sg + (dv0 + 1) * GL_SS, (unsigned short)(pk2(S.y, 0.f) & 0xffffu));
            lds_st<unsigned short>(sg + (dv0 + 2) * GL_SS, (unsigned short)(pk2(S.z, 0.f) & 0xffffu)); lds_st<unsigned short>(sg + (dv0 + 3) * GL_SS, (unsigned short)(pk2(S.w, 0.f) & 0xffffu));
            if (w < 7) { const int m = g * 8 + w; const float dd = ldg<float>(DD + (cb + m) * 32 + dk); const f32x4 ds = ldg<f32x4>(DS + (cb + m) * 2048 + e4); S = S * dd + ds; } } }
    const int n = g * 8 + c.wave; const size_t row0 = (size_t)b * SEQ + 64 * n;
    LAS unsigned char* vt = c.lds + c.wave * GL_VT; LAS unsigned char* sg = c.lds + GL_SG + c.wave * GL_SGW;
    gla_stage_vt(vt, P, row0, head, lane);
    wg_sync();
    bf16x8 ghi[2][2], glo[2][2]; gla_gate(P, row0, head, w2, gb, lane, ghi, glo);
    f32x16 bT[2]; bT[0] = zero16(); bT[1] = zero16(); const bf16x8 ones = ones_frag();
#pragma unroll
    for (int s = 0; s < 2; ++s) { const bf16x8 tri = tri_frag(s, lane);
        bT[0] = mfma32(ghi[0][s], tri, bT[0]); bT[0] = mfma32(glo[0][s], tri, bT[0]);
        bT[1] = mfma32(ghi[0][s], ones, bT[1]); bT[1] = mfma32(glo[0][s], ones, bT[1]); bT[1] = mfma32(ghi[1][s], tri, bT[1]); bT[1] = mfma32(glo[1][s], tri, bT[1]); }
    bf16x8 qf[2][2], kf[2][2];
    const float qscale = 0.17677669529663687f;
#pragma unroll
    for (int T = 0; T < 2; ++T)
#pragma unroll
        for (int s = 0; s < 2; ++s) { const bf16_t* qp = P + (row0 + 32 * T + cl) * NP + PC_GQ + 32 * head + 16 * s + 4 * h; const bf16_t* kp = qp + (PC_GK - PC_GQ);
            const u32x2 q0 = ldg<u32x2>(qp), q1 = ldg<u32x2>(qp + 8), k0 = ldg<u32x2>(kp), k1 = ldg<u32x2>(kp + 8);
            float eb[8];
#pragma unroll
            for (int j = 0; j < 8; ++j) eb[j] = bT[T][8 * s + j] * 1.4426950408889634f;
            u32x4 qo, ko;
            qo.x = pk2(bflo(q0.x) * fexp2(eb[0]) * qscale, bfhi(q0.x) * fexp2(eb[1]) * qscale); qo.y = pk2(bflo(q0.y) * fexp2(eb[2]) * qscale, bfhi(q0.y) * fexp2(eb[3]) * qscale);
            qo.z = pk2(bflo(q1.x) * fexp2(eb[4]) * qscale, bfhi(q1.x) * fexp2(eb[5]) * qscale); qo.w = pk2(bflo(q1.y) * fexp2(eb[6]) * qscale, bfhi(q1.y) * fexp2(eb[7]) * qscale);
            ko.x = pk2(bflo(k0.x) * fexp2(-eb[0]), bfhi(k0.x) * fexp2(-eb[1])); ko.y = pk2(bflo(k0.y) * fexp2(-eb[2]), bfhi(k0.y) * fexp2(-eb[3]));
            ko.z = pk2(bflo(k1.x) * fexp2(-eb[4]), bfhi(k1.x) * fexp2(-eb[5])); ko.w = pk2(bflo(k1.y) * fexp2(-eb[6]), bfhi(k1.y) * fexp2(-eb[7]));
            qf[T][s] = __builtin_bit_cast(bf16x8, qo); kf[T][s] = __builtin_bit_cast(bf16x8, ko); }
#pragma unroll
    for (int Ti = 0; Ti < 2; ++Ti) {
        f32x16 o[2]; o[0] = zero16(); o[1] = zero16();
#pragma unroll
        for (int V = 0; V < 2; ++V)
#pragma unroll
            for (int s = 0; s < 2; ++s) { LAS unsigned char* p = sg + (32 * V + cl) * GL_SS + (16 * s + 4 * h) * 2; const s16x4 lo = lds_ld<s16x4>(p), hi = lds_ld<s16x4>(p + 16);
                o[V] = mfma32(__builtin_shufflevector(lo, hi, 0, 1, 2, 3, 4, 5, 6, 7), qf[Ti][s], o[V]); }
#pragma unroll
        for (int Tj = 0; Tj <= Ti; ++Tj) { f32x16 a = zero16();
#pragma unroll
            for (int s = 0; s < 2; ++s) a = mfma32(kf[Tj][s], qf[Ti][s], a);
            if (Tj == Ti) {
#pragma unroll
                for (int e = 0; e < 16; ++e) a[e] = crow(e, h) <= cl ? a[e] : 0.f; }
#pragma unroll
            for (int s = 0; s < 2; ++s) { const bf16x8 pf = pack8(a, s);
#pragma unroll
                for (int V = 0; V < 2; ++V) o[V] = mfma32(gla_vfrag(vt, V, Tj, s, lane), pf, o[V]); } }
        float ss = 0.f;
#pragma unroll
        for (int V = 0; V < 2; ++V)
#pragma unroll
            for (int e = 0; e < 16; ++e) ss += o[V][e] * o[V][e];
        ss += shfl_xor_f(ss, 32); const float rstd = frsq(ss * (1.f / 64.f) + RMS_EPS); const size_t row = row0 + 32 * Ti + cl;
#pragma unroll
        for (int V = 0; V < 2; ++V)
#pragma unroll
            for (int g4 = 0; g4 < 4; ++g4) { const int dv0 = 32 * V + 8 * g4 + 4 * h; const u32x2 rr = ldg<u32x2>(P + row * NP + PC_GR + 64 * head + dv0); const f32x4 gn = ldg<f32x4>(gng + 64 * head + dv0);
                const float r0 = bflo(rr.x), r1 = bfhi(rr.x), r2 = bflo(rr.y), r3 = bfhi(rr.y);
                u32x2 w; w.x = pk2(o[V][4 * g4] * rstd * gn.x * r0 * fsigmoid(r0), o[V][4 * g4 + 1] * rstd * gn.y * r1 * fsigmoid(r1));
                w.y = pk2(o[V][4 * g4 + 2] * rstd * gn.z * r2 * fsigmoid(r2), o[V][4 * g4 + 3] * rstd * gn.w * r3 * fsigmoid(r3));
                stg<u32x2>(CAT + row * DM + CC_GLA + 64 * head + dv0, w); }
    }
    wg_sync();
}

struct LayerP { const float *w2, *gb, *gng, *cw, *cb, *clg, *clb, *sinks; };
DEV void mixer_m1(Ctx& c, const Bufs& B, const LayerP& L) {
#ifndef SKIP_SWA
    for (int it = c.bid; it < NBATCH * 2 * NBLK; it += c.G) swa_item(c, it, B.P, B.CAT, L.sinks);
#endif
#ifndef SKIP_CONV
    for (int it = c.bid; it < M / CV_T; it += c.G) conv_item(c, it, B.P, B.CAT, L.cw, L.cb, L.clg, L.clb);
#endif
#ifndef SKIP_GLA1
    for (int it = c.bid; it < NBATCH * 4 * NCH / 8; it += c.G) gla_m1_chunk(c, it * 8 + c.wave, B.P, B.DS, B.DD, L.w2, L.gb);
#endif
}
DEV void mixer_m2(Ctx& c, const Bufs& B, const LayerP& L) {
#ifndef SKIP_GLA2
    for (int it = c.bid; it < NBATCH * 4 * NCH / 8; it += c.G) gla_m2_group(c, it, B.P, B.CAT, B.DS, B.DD, L.w2, L.gb, L.gng);
#endif
}

struct GUnit { int pm, pn; };
struct EpiStore {
    static constexpr bool PERM = true, AFTER_DRAIN = false;
    bf16_t* O; int ldc;
    DEV void operator()(const f32x4 (&acc)[2][2][4][2], int pm, int pn, int wr, int wc, int fr, int fq) const {
        const int row0 = pm * 256 + wr * 64 + fr, col0 = pn * 256 + wc * 32 + 8 * fq;
#pragma unroll
        for (int ai = 0; ai < 2; ++ai)
#pragma unroll
            for (int m = 0; m < 4; ++m) { bf16_t* rowp = O + (size_t)(row0 + ai * 128 + m * 16) * ldc + col0;
#pragma unroll
                for (int bj = 0; bj < 2; ++bj) { const f32x4 v0 = acc[ai][bj][m][0], v1 = acc[ai][bj][m][1];
                    u32x4 w; w.x = pk2(v0[0], v0[1]); w.y = pk2(v0[2], v0[3]); w.z = pk2(v1[0], v1[1]); w.w = pk2(v1[2], v1[3]); stg<u32x4>(rowp + bj * 128, w); } }
    }
};
struct EpiSwiGLU {
    static constexpr bool PERM = true, AFTER_DRAIN = false;
    bf16_t* O; int ldc;
    DEV void operator()(const f32x4 (&acc)[2][2][4][2], int pm, int pn, int wr, int wc, int fr, int fq) const {
        const int row0 = pm * 256 + wr * 64 + fr, col0 = pn * 128 + wc * 32 + 8 * fq;
#pragma unroll
        for (int ai = 0; ai < 2; ++ai)
#pragma unroll
            for (int m = 0; m < 4; ++m) { float r[8];
#pragma unroll
                for (int n = 0; n < 2; ++n)
#pragma unroll
                    for (int e = 0; e < 4; ++e) { const float g = acc[ai][0][m][n][e], u = acc[ai][1][m][n][e]; r[4 * n + e] = g * fsigmoid(g) * u; }
                u32x4 w; w.x = pk2(r[0], r[1]); w.y = pk2(r[2], r[3]); w.z = pk2(r[4], r[5]); w.w = pk2(r[6], r[7]);
                stg<u32x4>(O + (size_t)(row0 + ai * 128 + m * 16) * ldc + col0, w); }
    }
};

#ifndef HOST_EMU
namespace pg8 {
constexpr int BM = 256, BK = 64, HALF = 128, HTB = HALF * BK * 2  , STAGE_BYTES = 8 * HTB, NXCD = 8, WGM = 8;
__device__ __forceinline__ int lds_byte(int r, int c) { const int st = (r >> 4) * 2 + (c >> 5), rr = r & 15, cc = c & 31, ob = rr * 64 + cc * 2; return st * 1024 + (ob ^ (((ob >> 9) & 1) << 5)); }
__device__ __forceinline__ void stage_rc(int b, int& R, int& C) { const int st = b / 1024, sb = b % 1024, swz = sb ^ (((sb >> 9) & 1) << 5); R = (st >> 1) * 16 + swz / 64; C = (st & 1) * 32 + (swz % 64) / 2; }
__device__ __forceinline__ int perm32(int rho) { const int n = rho >> 4, i = rho & 15; return 8 * (i >> 2) + 4 * n + (i & 3); }
struct Unit { int pm, pn; };
struct Gemm { const bf16_t* A; const bf16_t* Bt; int M, N, K; };
struct StaticOrder {
    int nM, nN, nwg, G, c;
    __device__ void init(int M_, int N_, int G_, int c_) { nM = M_ / BM; nN = N_ / BM; nwg = nM * nN; G = G_; c = c_; }
    __device__ bool next(int i, Unit& u) const {
        const long L = (long)i * G + c; if (L >= nwg) return false;
        int wgid = (int)L; { const int q = nwg / NXCD, r = nwg % NXCD, xcd = wgid % NXCD, off = wgid / NXCD; wgid = (xcd < r ? xcd * (q + 1) : r * (q + 1) + (xcd - r) * q) + off; }
        const int nig = WGM * nN, gid = wgid / nig, fm = gid * WGM, gsz = (nM - fm) < WGM ? (nM - fm) : WGM;
        u.pm = fm + ((wgid % nig) % gsz); u.pn = (wgid % nig) / gsz; return true;
    }
};
#define PG8_LAS __attribute__((address_space(3)))
template <class Epi, class Sched, bool ALIGN_EPI, bool SP2>
__device__ __forceinline__ void gemm_phase(PG8_LAS unsigned char* lds, const Gemm g, const Sched& S, const Epi& E) {
    int tid_ = threadIdx.x; asm volatile("" : "+v"(tid_));
    const int tid = tid_, wid = __builtin_amdgcn_readfirstlane(tid >> 6), lane = tid & 63, wr = wid >> 2, wc = wid & 3, fr = lane & 15, fq = lane >> 4;
    const int K = g.K, nt = K / BK;
    unsigned voffA[2], voffB[2];
#pragma unroll
    for (int i = 0; i < 2; ++i) { int R, C; stage_rc(tid * 16 + i * 8192, R, C); const int Rb = Epi::PERM ? ((R & ~31) + perm32(R & 31)) : R;
        voffA[i] = (unsigned)(R * K + C) * 2u; voffB[i] = (unsigned)(Rb * K + C) * 2u; }
    const size_t kstep = (size_t)(BK * 2);
    const size_t hstep = (size_t)HALF * K * 2;
    const size_t tstep = 2 * hstep;
    const unsigned ldsw = (unsigned)wid * 1024u;
    const int aoff = lds_byte(wr * 64 + fr, fq * 8), boff = lds_byte(wc * 32 + fr, fq * 8);
#define PG8_SA(b, h) (((b) * 2 + (h)) * HTB)
#define PG8_SB(b, h) ((4 + (b) * 2 + (h)) * HTB)
#define PG8_STAGE(bufoff, gbase, voff) do { _Pragma("unroll") for (int _i = 0; _i < 2; ++_i) \
        __builtin_amdgcn_global_load_lds((const unsigned*)((const char*)(gbase) + (voff)[_i]), (PG8_LAS unsigned*)(lds + (bufoff) + ldsw + _i * 8192), 16, 0, 0); } while (0)
#define PG8_LDA(dst, b, h) do { _Pragma("unroll") for (int m = 0; m < 4; ++m) _Pragma("unroll") for (int k = 0; k < 2; ++k) dst[m][k] = *(const PG8_LAS bf16x8*)(lds + PG8_SA(b, h) + aoff + m * 2048 + k * 1024); } while (0)
#define PG8_LDB(dst, b, h) do { _Pragma("unroll") for (int n = 0; n < 2; ++n) _Pragma("unroll") for (int k = 0; k < 2; ++k) dst[n][k] = *(const PG8_LAS bf16x8*)(lds + PG8_SB(b, h) + boff + n * 2048 + k * 1024); } while (0)
#define PG8_MMA(ai, bj, At, Bt) do { __builtin_amdgcn_s_setprio(1); _Pragma("unroll") for (int m = 0; m < 4; ++m) _Pragma("unroll") for (int n = 0; n < 2; ++n) _Pragma("unroll") for (int k = 0; k < 2; ++k) \
        acc[ai][bj][m][n] = __builtin_amdgcn_mfma_f32_16x16x32_bf16(Bt[n][k], At[m][k], acc[ai][bj][m][n], 0, 0, 0); __builtin_amdgcn_s_setprio(0); } while (0)
#define PG8_WAIT_V(n) asm volatile("s_waitcnt vmcnt(" #n ")" ::: "memory")
#define PG8_WAIT_L(n) asm volatile("s_waitcnt lgkmcnt(" #n ")" ::: "memory")
#define PG8_BAR __builtin_amdgcn_s_barrier()
#define PG8_SCHED __builtin_amdgcn_sched_barrier(0)
    Unit cur, nxt; int ui = 0;
    if (!S.next(0, cur)) return;
    f32x4 acc[2][2][4][2];
#pragma unroll
    for (int a = 0; a < 2; ++a)
#pragma unroll
        for (int b = 0; b < 2; ++b)
#pragma unroll
            for (int m = 0; m < 4; ++m)
#pragma unroll
                for (int n = 0; n < 2; ++n) acc[a][b][m][n] = (f32x4){0.f, 0.f, 0.f, 0.f};
    bf16x8 At[4][2], B0[2][2], B1[2][2];
    const char* cA = (const char*)g.A + (size_t)cur.pm * tstep; const char* cB = (const char*)g.Bt + (size_t)cur.pn * tstep;
    if constexpr (SP2) {
        PG8_STAGE(PG8_SB(0, 0), cB, voffB); PG8_STAGE(PG8_SB(0, 1), cB + hstep, voffB); PG8_STAGE(PG8_SA(0, 0), cA, voffA); PG8_STAGE(PG8_SA(0, 1), cA + hstep, voffA);
        if (wr == 1) PG8_BAR;
        PG8_WAIT_V(2); PG8_BAR;
        PG8_STAGE(PG8_SB(1, 0), cB + kstep, voffB); PG8_STAGE(PG8_SA(1, 0), cA + kstep, voffA); PG8_STAGE(PG8_SB(1, 1), cB + hstep + kstep, voffB);
        PG8_WAIT_V(6); PG8_BAR;
    } else {
        PG8_STAGE(PG8_SB(0, 0), cB, voffB); PG8_STAGE(PG8_SA(0, 0), cA, voffA); PG8_STAGE(PG8_SB(0, 1), cB + hstep, voffB); PG8_STAGE(PG8_SA(0, 1), cA + hstep, voffA);
        if (wr == 1) PG8_BAR;
        PG8_WAIT_V(4); PG8_BAR;
        PG8_STAGE(PG8_SB(1, 0), cB + kstep, voffB); PG8_STAGE(PG8_SA(1, 0), cA + kstep, voffA); PG8_STAGE(PG8_SB(1, 1), cB + hstep + kstep, voffB);
        PG8_WAIT_V(6); PG8_BAR;
    }
    for (;;) {
        const bool has_next = S.next(ui + 1, nxt);
        const char* nA = has_next ? (const char*)g.A + (size_t)nxt.pm * tstep : cA; const char* nB = has_next ? (const char*)g.Bt + (size_t)nxt.pn * tstep : cB;
        for (int t = 0; t < nt; t += 2) {
            const bool last = (t == nt - 2);
            const char* a1 = cA + (size_t)(t + 1) * kstep;
            const char* a2 = last ? nA : cA + (size_t)(t + 2) * kstep; const char* b2 = last ? nB : cB + (size_t)(t + 2) * kstep;
            const char* a3 = a2 + kstep; const char* b3 = b2 + kstep;
            if constexpr (SP2) {
            PG8_LDB(B0, 0, 0); PG8_LDB(B1, 0, 1); PG8_SCHED; PG8_LDA(At, 0, 0); PG8_STAGE(PG8_SA(1, 1), a1 + hstep, voffA);
            PG8_WAIT_V(8); PG8_WAIT_L(0); PG8_BAR; PG8_MMA(0, 0, At, B0); PG8_MMA(0, 1, At, B1); PG8_BAR; PG8_SCHED;
            PG8_LDA(At, 0, 1); PG8_STAGE(PG8_SB(0, 0), b2, voffB); PG8_STAGE(PG8_SB(0, 1), b2 + hstep, voffB); PG8_STAGE(PG8_SA(0, 0), a2, voffA);
            PG8_WAIT_V(8); PG8_WAIT_L(0); PG8_BAR; PG8_MMA(1, 0, At, B0); PG8_MMA(1, 1, At, B1); PG8_BAR; PG8_SCHED;
            PG8_LDB(B0, 1, 0); PG8_LDB(B1, 1, 1); PG8_SCHED; PG8_LDA(At, 1, 0); PG8_STAGE(PG8_SA(0, 1), a2 + hstep, voffA);
            PG8_WAIT_V(8); PG8_WAIT_L(0); PG8_BAR; PG8_MMA(0, 0, At, B0); PG8_MMA(0, 1, At, B1); PG8_BAR; PG8_SCHED;
            PG8_LDA(At, 1, 1); PG8_STAGE(PG8_SB(1, 0), b3, voffB); PG8_STAGE(PG8_SB(1, 1), b3 + hstep, voffB); PG8_STAGE(PG8_SA(1, 0), a3, voffA);
            PG8_WAIT_V(8); PG8_WAIT_L(0); PG8_BAR; PG8_MMA(1, 0, At, B0); PG8_MMA(1, 1, At, B1); PG8_BAR; PG8_SCHED;
            } else {
            PG8_LDB(B0, 0, 0); PG8_SCHED; PG8_LDA(At, 0, 0); PG8_STAGE(PG8_SA(1, 1), a1 + hstep, voffA);
            PG8_WAIT_L(8); PG8_BAR; PG8_WAIT_L(0); PG8_MMA(0, 0, At, B0); PG8_BAR; PG8_SCHED;
            PG8_LDB(B1, 0, 1); PG8_STAGE(PG8_SB(0, 0), b2, voffB);
            PG8_BAR; PG8_WAIT_L(0); PG8_MMA(0, 1, At, B1); PG8_BAR;
            PG8_LDA(At, 0, 1); PG8_STAGE(PG8_SA(0, 0), a2, voffA);
            PG8_BAR; PG8_WAIT_L(0); PG8_MMA(1, 0, At, B0); PG8_BAR; PG8_SCHED;
            PG8_STAGE(PG8_SB(0, 1), b2 + hstep, voffB);
            PG8_WAIT_V(6); PG8_BAR; PG8_MMA(1, 1, At, B1); PG8_BAR;
            PG8_LDB(B0, 1, 0); PG8_SCHED; PG8_LDA(At, 1, 0); PG8_STAGE(PG8_SA(0, 1), a2 + hstep, voffA);
            PG8_WAIT_L(8); PG8_BAR; PG8_WAIT_L(0); PG8_MMA(0, 0, At, B0); PG8_BAR; PG8_SCHED;
            PG8_LDB(B1, 1, 1); PG8_STAGE(PG8_SB(1, 0), b3, voffB);
            PG8_BAR; PG8_WAIT_L(0); PG8_MMA(0, 1, At, B1); PG8_BAR;
            PG8_LDA(At, 1, 1); PG8_STAGE(PG8_SA(1, 0), a3, voffA);
            PG8_BAR; PG8_WAIT_L(0); PG8_MMA(1, 0, At, B0); PG8_BAR; PG8_SCHED;
            PG8_STAGE(PG8_SB(1, 1), b3 + hstep, voffB);
            PG8_WAIT_V(6); PG8_BAR; PG8_MMA(1, 1, At, B1); PG8_BAR;
            }
        }
        if constexpr (ALIGN_EPI) { if (wr == 0) PG8_BAR; }
        E(acc, cur.pm, cur.pn, wr, wc, fr, fq);
        if (!has_next) break;
#pragma unroll
        for (int a = 0; a < 2; ++a)
#pragma unroll
            for (int b = 0; b < 2; ++b)
#pragma unroll
                for (int m = 0; m < 4; ++m)
#pragma unroll
                    for (int n = 0; n < 2; ++n) acc[a][b][m][n] = (f32x4){0.f, 0.f, 0.f, 0.f};
        cur = nxt; cA = nA; cB = nB; ++ui;
        if constexpr (ALIGN_EPI) { if (wr == 1) PG8_BAR; }
    }
    PG8_WAIT_V(0);
    if constexpr (!ALIGN_EPI) { if (wr == 0) PG8_BAR; }
    PG8_BAR;
#undef PG8_SA
#undef PG8_SB
#undef PG8_STAGE
#undef PG8_LDA
#undef PG8_LDB
#undef PG8_MMA
#undef PG8_WAIT_V
#undef PG8_WAIT_L
#undef PG8_BAR
#undef PG8_SCHED
}
}

#define XB_TMO      128
#define XB_XCNT(j)  (256  + 64 * (j))
#define XB_XSUB(j)  (1280 + 64 * (j))
#define XB_XGEN(j)  (2304 + 64 * (j))
#define XB_TOP      3328
#define XB_TOPGEN   3392
#define XCD_BAR_WORDS 3456
#define XB_SPIN_CAP (1u << 18)
__device__ __forceinline__ unsigned xb_ld(unsigned* p)              { return __hip_atomic_load(p, __ATOMIC_RELAXED, __HIP_MEMORY_SCOPE_AGENT); }
__device__ __forceinline__ unsigned xb_add(unsigned* p, unsigned v) { return __hip_atomic_fetch_add(p, v, __ATOMIC_RELAXED, __HIP_MEMORY_SCOPE_AGENT); }
__device__ __forceinline__ unsigned xb_xcc_id() { return (unsigned)__builtin_amdgcn_s_getreg((3 << 11) | 20) & 0xFu; }
#define XB_SPIN(cond, bar) do { unsigned _sp = 0; while (cond) { __builtin_amdgcn_s_sleep(1); \
    if ((++_sp & 255u) == 0u) { if (xb_ld(&(bar)[XB_TMO])) break; if (_sp > XB_SPIN_CAP) { atomicAdd(&(bar)[XB_TMO], 1u); break; } } } } while (0)
struct XcdBarrier {
    unsigned* bar; unsigned x;
    volatile LAS unsigned* st;
};
__device__ __forceinline__ XcdBarrier xcd_barrier_post(unsigned* bar, volatile LAS unsigned* st) {
    XcdBarrier b; b.bar = bar; b.x = xb_xcc_id(); b.st = st;
    if (threadIdx.x == 0) (void)xb_add(&bar[XB_XCNT(b.x)], 1u);
    return b;
}
__device__ __forceinline__ void xcd_barrier_complete(unsigned* bar, unsigned x, unsigned& nloc, unsigned& nx) {
    const unsigned G = gridDim.x * gridDim.y * gridDim.z;
    unsigned sum, cnt, mine, sp = 0u;
    for (;;) {
        sum = 0u; cnt = 0u; mine = 0u;
#pragma unroll
        for (unsigned j = 0; j < 16; ++j) { const unsigned c = xb_ld(&bar[XB_XCNT(j)]); sum += c; cnt += (c > 0u) ? 1u : 0u; mine = (j == x) ? c : mine; }
        if (sum == G) break;
        __builtin_amdgcn_s_sleep(1);
        if ((++sp & 255u) == 0u) { if (xb_ld(&bar[XB_TMO])) break; if (sp > XB_SPIN_CAP) { atomicAdd(&bar[XB_TMO], 1u); break; } }
    }
    nloc = mine > 0u ? mine : 1u; nx = cnt > 0u ? cnt : 1u;
}
__device__ __forceinline__ void xcd_barrier(const XcdBarrier& b) {
    asm volatile("s_waitcnt vmcnt(0)" ::: "memory");
    __syncthreads();
    if (threadIdx.x == 0) {
        unsigned* bar = b.bar;
        __builtin_amdgcn_s_waitcnt(0);
        unsigned nloc = b.st[0], nx = b.st[1];
        if (nloc == 0u) { xcd_barrier_complete(bar, b.x, nloc, nx); b.st[0] = nloc; b.st[1] = nx; }
        const unsigned old = xb_add(&bar[XB_XSUB(b.x)], 1u);
        const unsigned gen = old / nloc;
        if (old + 1u == (gen + 1u) * nloc) {
            __builtin_amdgcn_fence(__ATOMIC_RELEASE, "agent");
            asm volatile("s_waitcnt vmcnt(0)" ::: "memory");
            const unsigned og = xb_add(&bar[XB_TOP], 1u);
            const unsigned tg = og / nx;
            if (og + 1u == (tg + 1u) * nx) xb_add(&bar[XB_TOPGEN], 1u);
            else XB_SPIN(xb_ld(&bar[XB_TOPGEN]) == tg, bar);
            __builtin_amdgcn_fence(__ATOMIC_ACQUIRE, "agent");
            xb_add(&bar[XB_XGEN(b.x)], 1u);
            asm volatile("s_waitcnt vmcnt(0)" ::: "memory");
        } else {
            XB_SPIN(xb_ld(&bar[XB_XGEN(b.x)]) == gen, bar);
            __builtin_amdgcn_fence(__ATOMIC_ACQUIRE, "agent");
            asm volatile("s_waitcnt vmcnt(0)" ::: "memory");
        }
    }
    __syncthreads();
}

constexpr size_t MiB = 1u << 20;
constexpr size_t al(size_t x) { return (x + MiB - 1) / MiB * MiB; }
constexpr size_t WS_CTL = 0, CTL_ZERO_BYTES = 1 * MiB;
constexpr size_t WS_WGU = WS_CTL + CTL_ZERO_BYTES, SZ_WGU = (size_t)4 * NGU * DM * 2;
constexpr size_t WS_WD = al(WS_WGU + SZ_WGU), SZ_WD = (size_t)4 * DM * DFF * 2;
constexpr size_t WS_WIN = al(WS_WD + SZ_WD), SZ_WIN = (size_t)2 * NP * DM * 2;
constexpr size_t WS_WOUT = al(WS_WIN + SZ_WIN), SZ_WOUT = (size_t)2 * DM * DM * 2;
constexpr size_t WS_XN = al(WS_WOUT + SZ_WOUT), SZ_XN = (size_t)M * DM * 2;
constexpr size_t WS_H = al(WS_XN + SZ_XN), SZ_H = (size_t)M * DM * 2;
constexpr size_t WS_ACT = al(WS_H + SZ_H), SZ_ACT = (size_t)M * DFF * 2;
constexpr size_t WS_CAT = al(WS_ACT + SZ_ACT), SZ_CAT = (size_t)M * DM * 2;
constexpr size_t WS_DS = al(WS_CAT + SZ_CAT), SZ_DS = (size_t)NBATCH * 4 * NCH * 2048 * 4;
constexpr size_t WS_DD = al(WS_DS + SZ_DS), SZ_DD = (size_t)NBATCH * 4 * NCH * 32 * 4;
constexpr size_t WS_END = al(WS_DD + SZ_DD);
static_assert((size_t)M * NP * 2 <= SZ_ACT, "P overlays ACT");
constexpr int CW_BAR = 4096;
static_assert((CW_BAR + XCD_BAR_WORDS) * 4 <= (int)CTL_ZERO_BYTES, "control words");

constexpr int RING_BYTES = 131072, MISC_OFF = RING_BYTES + 320, LDS_BYTES = 147456;

struct Args { const float* in[15]; float* out; unsigned char* ws; int ph_lo, ph_hi; };

__device__ __forceinline__ bool relaunder(Ctx& c) { int t = threadIdx.x; asm volatile("" : "+v"(t)); c.tid = t; c.lane = t & 63; c.wave = __builtin_amdgcn_readfirstlane(t >> 6); return true; }
__global__ void __launch_bounds__(512, 2) fwd_kernel(Args args) {
    extern __shared__ __attribute__((aligned(16))) unsigned char lds_raw[];
    Ctx c; c.lds = (LAS unsigned char*)lds_raw; c.tid = threadIdx.x; c.lane = c.tid & 63; c.wave = __builtin_amdgcn_readfirstlane(c.tid >> 6);
    c.G = gridDim.x; { const int bx = blockIdx.x; c.bid = (c.G % 8 == 0) ? (bx % 8) * (c.G / 8) + bx / 8 : bx; }
    volatile LAS unsigned* MISC = (volatile LAS unsigned*)(c.lds + MISC_OFF);
    for (int u = c.tid; u < (LDS_BYTES - RING_BYTES) / 4; u += 512) ((LAS unsigned*)(c.lds + RING_BYTES))[u] = 0u;
    __syncthreads();
    unsigned char* ws = args.ws;
    XcdBarrier bar = xcd_barrier_post((unsigned*)(ws + WS_CTL) + CW_BAR, MISC + 8);
    Inputs in; in.x = args.in[0]; in.norm_g = args.in[1]; in.wg = args.in[2]; in.wu = args.in[3]; in.wd = args.in[4]; in.win = args.in[5]; in.gw2 = args.in[6]; in.gb = args.in[7];
    in.gng = args.in[8]; in.cw = args.in[9]; in.cb = args.in[10]; in.clg = args.in[11]; in.clb = args.in[12]; in.sinks = args.in[13]; in.wout = args.in[14];
    Bufs B; B.Wgu = (bf16_t*)(ws + WS_WGU); B.Wd = (bf16_t*)(ws + WS_WD); B.Win = (bf16_t*)(ws + WS_WIN); B.Wout = (bf16_t*)(ws + WS_WOUT); B.XN = (bf16_t*)(ws + WS_XN); B.H = (bf16_t*)(ws + WS_H);
    B.ACT = (bf16_t*)(ws + WS_ACT); B.P = (bf16_t*)(ws + WS_ACT); B.CAT = (bf16_t*)(ws + WS_CAT); B.DS = (float*)(ws + WS_DS); B.DD = (float*)(ws + WS_DD); B.X = args.out;
    const int lo = args.ph_lo, hi = args.ph_hi; int ph = 0;
#define RUN() (ph >= lo && ph < hi && relaunder(c))
#define SEAM() do { if (ph >= lo && ph + 1 < hi) xcd_barrier(bar); ++ph; } while (0)
    if (RUN()) prologue_phase(c, in, B);
    SEAM();
#pragma unroll 1
    for (int step = 0; step < 2 * DEPTH; ++step) {
        const int l = step >> 1, f = step & 1;
        if (RUN()) { pg8::Gemm g{B.XN, B.Wgu + (size_t)step * NGU * DM, M, NGU, DM}; pg8::StaticOrder S; S.init(M, NGU, c.G, (int)blockIdx.x);
            EpiSwiGLU E{B.ACT, DFF}; pg8::gemm_phase<EpiSwiGLU, pg8::StaticOrder, true, true>(c.lds, g, S, E); }
        SEAM();
        if (RUN()) { pg8::Gemm g{B.ACT, B.Wd + (size_t)step * DM * DFF, M, DM, DFF}; pg8::StaticOrder S; S.init(M, DM, c.G, (int)blockIdx.x);
            EpiStore E{B.H, DM}; pg8::gemm_phase<EpiStore, pg8::StaticOrder, true, true>(c.lds, g, S, E); }
        SEAM();
        if (RUN()) thin_phase(c, B.H, step == 0 ? in.x : B.X, B.X, B.XN, in.norm_g + (l * 6 + (f ? 5 : 1)) * DM, 0.5f, step != 2 * DEPTH - 1);
        SEAM();
        if (f == 0) {
            LayerP L; L.w2 = in.gw2 + l * 16 * 128; L.gb = in.gb + l * 128; L.gng = in.gng + l * 256; L.cw = in.cw + l * 31 * 256; L.cb = in.cb + l * 256; L.clg = in.clg + l * 256; L.clb = in.clb + l * 256; L.sinks = in.sinks + l * 8;
            if (RUN()) { pg8::Gemm g{B.XN, B.Win + (size_t)l * NP * DM, M, NP, DM}; pg8::StaticOrder S; S.init(M, NP, c.G, (int)blockIdx.x);
                EpiStore E{B.P, NP}; pg8::gemm_phase<EpiStore, pg8::StaticOrder, true, true>(c.lds, g, S, E); }
            SEAM();
            if (RUN()) mixer_m1(c, B, L);
            SEAM();
            if (RUN()) mixer_m2(c, B, L);
            SEAM();
            if (RUN()) { pg8::Gemm g{B.CAT, B.Wout + (size_t)l * DM * DM, M, DM, DM}; pg8::StaticOrder S; S.init(M, DM, c.G, (int)blockIdx.x);
                EpiStore E{B.H, DM}; pg8::gemm_phase<EpiStore, pg8::StaticOrder, true, true>(c.lds, g, S, E); }
            SEAM();
            if (RUN()) thin_phase(c, B.H, B.X, B.X, B.XN, in.norm_g + (l * 6 + 3) * DM, 1.0f, true);
            SEAM();
        }
    }
#undef RUN
#undef SEAM
}

constexpr int N_PHASES = 1 + 4 * 3 + 2 * 5;
#ifndef MK_N_LAUNCHES
#define MK_N_LAUNCHES 1
#endif
extern "C" void kernel_launch(void* const* d_in, const int* in_sizes, int n_in, void* d_out, int out_size, void* d_ws, size_t ws_size, hipStream_t stream) {
    static int grid = 0;
    if (grid == 0) {
        if (n_in != 15 || in_sizes[0] != M * DM || out_size != M * DM || ws_size < WS_END) { fprintf(stderr, "kernel_launch: unexpected shapes (n_in %d, in0 %d, out %d, ws %zu < %zu); nothing launched\n", n_in, n_in > 0 ? in_sizes[0] : -1, out_size, ws_size, (size_t)WS_END); grid = -1; return; }
        int dev = 0, cus = 0, per_cu = 0;
        if (hipGetDevice(&dev) != hipSuccess || hipDeviceGetAttribute(&cus, hipDeviceAttributeMultiprocessorCount, dev) != hipSuccess) { grid = -1; return; }
        if (hipFuncSetAttribute((const void*)fwd_kernel, hipFuncAttributeMaxDynamicSharedMemorySize, LDS_BYTES) != hipSuccess) { fprintf(stderr, "kernel_launch: hipFuncSetAttribute failed\n"); grid = -1; return; }
        if (hipOccupancyMaxActiveBlocksPerMultiprocessor(&per_cu, (const void*)fwd_kernel, 512, LDS_BYTES) != hipSuccess || per_cu < 1) { fprintf(stderr, "kernel_launch: occupancy query says %d workgroups per CU\n", per_cu); }
        (void)hipGetLastError();
        grid = cus;
    }
    if (grid < 0) return;
    if (hipMemsetAsync((char*)d_ws + WS_CTL, 0, CTL_ZERO_BYTES, stream) != hipSuccess) return;
    Args a{};
    for (int i = 0; i < 15; ++i) a.in[i] = (const float*)d_in[i];
    a.out = (float*)d_out; a.ws = (unsigned char*)d_ws;
    if (MK_N_LAUNCHES == 1) { a.ph_lo = 0; a.ph_hi = N_PHASES; hipLaunchKernelGGL(fwd_kernel, dim3(grid), dim3(512), LDS_BYTES, stream, a); }
    else for (int p = 0; p < N_PHASES; ++p) { a.ph_lo = p; a.ph_hi = p + 1; hipLaunchKernelGGL(fwd_kernel, dim3(grid), dim3(512), LDS_BYTES, stream, a); }
}
#endif
```

```cpp
#ifndef HOST_EMU
#include <hip/hip_runtime.h>
#include <cstdio>
#include <cstdint>
#define DEV __device__ __forceinline__
#define LAS __attribute__((address_space(3)))
#define GAS __attribute__((address_space(1)))
#endif

#ifndef CFG_BATCH
#define CFG_BATCH 8
#endif
#ifndef CFG_SEQ
#define CFG_SEQ 4096
#endif
constexpr int NBATCH = CFG_BATCH, SEQ = CFG_SEQ, M = NBATCH * SEQ;
constexpr int DM = 1024, DFF = 2816, DIN = 2064, NGU = 2 * DFF, DEPTH = 2;
constexpr int NP = 2304;
constexpr int PC_GQ = 0, PC_GK = 128, PC_GV = 256, PC_GR = 512, PC_CA = 768, PC_CG = 1024, PC_SQ = 1280, PC_SK = 1792, PC_SV = 1920, PC_GLR = 2048;
constexpr int CC_GLA = 0, CC_CONV = 256, CC_SWA = 512;
constexpr int NCH = SEQ / 64;
constexpr int NBLK = SEQ / 128;
constexpr float RMS_EPS = 1e-6f, LN_EPS = 1e-5f;
static_assert(M % 256 == 0 && SEQ % 512 == 0, "shape");

typedef unsigned short bf16_t;
typedef short bf16x8 __attribute__((ext_vector_type(8)));
typedef short s16x4 __attribute__((ext_vector_type(4)));
typedef float f32x4 __attribute__((ext_vector_type(4)));
typedef float f32x16 __attribute__((ext_vector_type(16)));
typedef unsigned u32x4 __attribute__((ext_vector_type(4)));
typedef unsigned u32x2 __attribute__((ext_vector_type(2)));

#ifndef HOST_EMU
DEV f32x16 mfma32(bf16x8 a, bf16x8 b, f32x16 c) { return __builtin_amdgcn_mfma_f32_32x32x16_bf16(a, b, c, 0, 0, 0); }
DEV float shfl_xor_f(float v, int m) { return __shfl_xor(v, m); }
DEV float shfl_f(float v, int src) { return __shfl(v, src); }
DEV void wg_sync() { __syncthreads(); }
DEV void wave_sync() { asm volatile("s_waitcnt lgkmcnt(0)" ::: "memory"); }
typedef float f32x2_t __attribute__((ext_vector_type(2)));
typedef __bf16 bf16x2_t __attribute__((ext_vector_type(2)));
DEV unsigned pk2(float lo, float hi) { const f32x2_t v = {lo, hi}; const bf16x2_t b = __builtin_convertvector(v, bf16x2_t); return __builtin_bit_cast(unsigned, b); }
DEV float fexp2(float x) { return __builtin_amdgcn_exp2f(x); }
DEV float flog2(float x) { return __builtin_amdgcn_logf(x); }
DEV float frcp(float x) { return __builtin_amdgcn_rcpf(x); }
DEV float frsq(float x) { return __builtin_amdgcn_rsqf(x); }
template <class T> DEV T ldg(const void* p) { return *(const GAS T*)p; }
template <class T> DEV void stg(void* p, T v) { *(GAS T*)p = v; }
template <class T> DEV T lds_ld(LAS unsigned char* p) { return *(LAS T*)p; }
template <class T> DEV void lds_st(LAS unsigned char* p, T v) { *(LAS T*)p = v; }
#endif
DEV float bf2f(unsigned short b) { return __builtin_bit_cast(float, (unsigned)b << 16); }
DEV float bflo(unsigned w) { return __builtin_bit_cast(float, w << 16); }
DEV float bfhi(unsigned w) { return __builtin_bit_cast(float, w & 0xffff0000u); }
DEV float fexp(float x) { return fexp2(x * 1.4426950408889634f); }
DEV float fsigmoid(float x) { return frcp(1.0f + fexp(-x)); }
DEV float wave_sum(float v) {
#pragma unroll
    for (int o = 1; o < 64; o <<= 1) v += shfl_xor_f(v, o);
    return v;
}
DEV int crow(int reg, int h) { return (reg & 3) + 8 * (reg >> 2) + 4 * h; }
DEV bf16x8 pack8(const f32x16& x, int s) {
    u32x4 p; p.x = pk2(x[8 * s], x[8 * s + 1]); p.y = pk2(x[8 * s + 2], x[8 * s + 3]); p.z = pk2(x[8 * s + 4], x[8 * s + 5]); p.w = pk2(x[8 * s + 6], x[8 * s + 7]);
    return __builtin_bit_cast(bf16x8, p);
}
DEV f32x16 zero16() { f32x16 z; for (int i = 0; i < 16; ++i) z[i] = 0.f; return z; }

struct Ctx { LAS unsigned char* lds; int tid, lane, wave, bid, G; };

DEV int rowmap(int mode, int n) {
    if (mode == 0) return n;
    if (mode == 1) return ((n >> 7) << 8) + (n & 127);
    if (mode == 2) return ((n >> 7) << 8) + 128 + (n & 127);
    return n < 768 ? n : (n < 784 ? 2048 + (n - 768) : n - 16);
}
struct TrItem { const float* W; bf16_t* WT; const float* gain; int K, N, k0, n0, mode; };
DEV void tr_load(const TrItem& t, int lane, f32x4 (&v)[8]) {
    const int kr = lane >> 4, c4 = lane & 15, col = t.n0 + 4 * c4;
#pragma unroll
    for (int i = 0; i < 8; ++i) { const int k = t.k0 + 4 * i + kr; f32x4 x = (f32x4){0.f, 0.f, 0.f, 0.f}; if (col < t.N) x = ldg<f32x4>(t.W + (size_t)k * t.N + col); if (t.gain) x = x * ldg<float>(t.gain + k); v[i] = x; }
}
DEV void tr_store(const TrItem& t, int lane, const f32x4 (&v)[8], LAS unsigned char* scrb) {
    const int kr = lane >> 4, c4 = lane & 15;
#pragma unroll
    for (int i = 0; i < 8; ++i) { const int k = 4 * i + kr;
#pragma unroll
        for (int q = 0; q < 4; ++q) lds_st<float>(scrb + ((4 * c4 + q) * 33 + k) * 4, v[i][q]); }
    wave_sync();
    const int nr = lane >> 2, c8 = lane & 3;
#pragma unroll
    for (int j = 0; j < 4; ++j) { const int n = 16 * j + nr; LAS unsigned char* p = scrb + (n * 33 + 8 * c8) * 4;
        u32x4 o; o.x = pk2(lds_ld<float>(p), lds_ld<float>(p + 4)); o.y = pk2(lds_ld<float>(p + 8), lds_ld<float>(p + 12)); o.z = pk2(lds_ld<float>(p + 16), lds_ld<float>(p + 20)); o.w = pk2(lds_ld<float>(p + 24), lds_ld<float>(p + 28));
        if (t.n0 + n < t.N) stg<u32x4>(t.WT + (size_t)rowmap(t.mode, t.n0 + n) * t.K + t.k0 + 8 * c8, o); }
    wave_sync();
}
struct Inputs { const float *x, *norm_g, *wg, *wu, *wd, *win, *gw2, *gb, *gng, *cw, *cb, *clg, *clb, *sinks, *wout; };
struct Bufs { bf16_t *Wgu, *Wd, *Win, *Wout, *XN, *H, *ACT, *P, *CAT; float *DS, *DD; float* X; };
constexpr int I_GU = (DM / 32) * (DFF / 64), I_D = (DFF / 32) * (DM / 64), I_IN = (DM / 32) * ((DIN + 63) / 64), I_OUT = (DM / 32) * (DM / 64);
constexpr int NITEMS_W = 8 * I_GU + 4 * I_D + 2 * I_IN + 2 * I_OUT;

DEV void rms_row_to_bf16(const float* xrow, bf16_t* orow, int lane) {
    f32x4 v[4]; float s = 0.f;
#pragma unroll
    for (int j = 0; j < 4; ++j) { v[j] = ldg<f32x4>(xrow + 4 * lane + 256 * j); s += (v[j].x * v[j].x + v[j].y * v[j].y) + (v[j].z * v[j].z + v[j].w * v[j].w); }
    const float r = frsq(wave_sum(s) * (1.f / DM) + RMS_EPS);
#pragma unroll
    for (int j = 0; j < 4; ++j) { u32x2 o; o.x = pk2(v[j].x * r, v[j].y * r); o.y = pk2(v[j].z * r, v[j].w * r); stg<u32x2>(orow + 4 * lane + 256 * j, o); }
}
DEV TrItem tr_decode(int it, const Inputs& in, const Bufs& B) {
    TrItem t; int r = it;
    if (r < 8 * I_GU) { const int q = r / I_GU, i = r % I_GU, lf = q >> 1, up = q & 1, l = lf >> 1, f = lf & 1; constexpr int nb = DFF / 64;
        t.W = (up ? in.wu : in.wg) + (size_t)lf * DM * DFF; t.K = DM; t.N = DFF; t.k0 = 32 * (i / nb); t.n0 = 64 * (i % nb); t.WT = B.Wgu + (size_t)lf * NGU * DM; t.mode = up ? 2 : 1; t.gain = in.norm_g + (l * 6 + (f ? 4 : 0)) * DM; return t; }
    r -= 8 * I_GU;
    if (r < 4 * I_D) { const int lf = r / I_D, i = r % I_D; constexpr int nb = DM / 64;
        t.W = in.wd + (size_t)lf * DFF * DM; t.K = DFF; t.N = DM; t.k0 = 32 * (i / nb); t.n0 = 64 * (i % nb); t.WT = B.Wd + (size_t)lf * DM * DFF; t.mode = 0; t.gain = nullptr; return t; }
    r -= 4 * I_D;
    if (r < 2 * I_IN) { const int l = r / I_IN, i = r % I_IN; constexpr int nb = (DIN + 63) / 64;
        t.W = in.win + (size_t)l * DM * DIN; t.K = DM; t.N = DIN; t.k0 = 32 * (i / nb); t.n0 = 64 * (i % nb); t.WT = B.Win + (size_t)l * NP * DM; t.mode = 3; t.gain = in.norm_g + (l * 6 + 2) * DM; return t; }
    r -= 2 * I_IN;
    { const int l = r / I_OUT, i = r % I_OUT; constexpr int nb = DM / 64;
        t.W = in.wout + (size_t)l * DM * DM; t.K = DM; t.N = DM; t.k0 = 32 * (i / nb); t.n0 = 64 * (i % nb); t.WT = B.Wout + (size_t)l * DM * DM; t.mode = 0; t.gain = nullptr; return t; }
}
DEV void prologue_phase(Ctx& c, const Inputs& in, const Bufs& B) {
    LAS unsigned char* scr = c.lds + c.wave * 16384;
    const int gw = c.bid * 8 + c.wave, NGW = c.G * 8;
    { int it = gw; f32x4 cur[8], nxt[8]; TrItem tc, tn;
        if (it < NITEMS_W) { tc = tr_decode(it, in, B); tr_load(tc, c.lane, cur); }
        while (it < NITEMS_W) { const int itn = it + NGW; const bool more = itn < NITEMS_W;
            if (more) { tn = tr_decode(itn, in, B); tr_load(tn, c.lane, nxt); }
            tr_store(tc, c.lane, cur, scr);
            if (more) { tc = tn;
#pragma unroll
                for (int i = 0; i < 8; ++i) cur[i] = nxt[i]; }
            it = itn; } }
    constexpr int PADV = (NP - DIN) * DM / 8;
    for (int q = c.bid * 512 + c.tid; q < 2 * PADV; q += c.G * 512) { const int l = q / PADV, i = q % PADV; stg<u32x4>(B.Win + (size_t)l * NP * DM + (size_t)DIN * DM + (size_t)i * 8, (u32x4){0u, 0u, 0u, 0u}); }
    for (int m = gw; m < M; m += NGW) rms_row_to_bf16(in.x + (size_t)m * DM, B.XN + (size_t)m * DM, c.lane);
}

DEV void thin_phase(Ctx& c, const bf16_t* H, const float* xin, float* xout, bf16_t* XN, const float* gain, float alpha, bool write_xn) {
    const int gw = c.bid * 8 + c.wave, NGW = c.G * 8, lane = c.lane;
    f32x4 g[4];
#pragma unroll
    for (int j = 0; j < 4; ++j) g[j] = ldg<f32x4>(gain + 4 * lane + 256 * j);
    for (int m = gw; m < M; m += NGW) {
        f32x4 hv[4], xv[4]; float s = 0.f;
#pragma unroll
        for (int j = 0; j < 4; ++j) { const u32x2 w = ldg<u32x2>(H + (size_t)m * DM + 4 * lane + 256 * j); xv[j] = ldg<f32x4>(xin + (size_t)m * DM + 4 * lane + 256 * j);
            hv[j] = (f32x4){bflo(w.x), bfhi(w.x), bflo(w.y), bfhi(w.y)}; s += (hv[j].x * hv[j].x + hv[j].y * hv[j].y) + (hv[j].z * hv[j].z + hv[j].w * hv[j].w); }
        const float rs = frsq(wave_sum(s) * (1.f / DM) + RMS_EPS) * alpha; float s2 = 0.f;
#pragma unroll
        for (int j = 0; j < 4; ++j) { xv[j] = xv[j] + hv[j] * g[j] * rs; stg<f32x4>(xout + (size_t)m * DM + 4 * lane + 256 * j, xv[j]);
            s2 += (xv[j].x * xv[j].x + xv[j].y * xv[j].y) + (xv[j].z * xv[j].z + xv[j].w * xv[j].w); }
        if (write_xn) { const float r2 = frsq(wave_sum(s2) * (1.f / DM) + RMS_EPS);
#pragma unroll
            for (int j = 0; j < 4; ++j) { u32x2 o; o.x = pk2(xv[j].x * r2, xv[j].y * r2); o.y = pk2(xv[j].z * r2, xv[j].w * r2); stg<u32x2>(XN + (size_t)m * DM + 4 * lane + 256 * j, o); } }
    }
}

constexpr int CV_T = 64, CV_U = 0, CV_Y = 49152;
DEV void conv_item(Ctx& c, int item, const bf16_t* P, bf16_t* CAT, const float* cw, const float* cb, const float* lng, const float* lnb) {
    const int t0 = item * CV_T, s0 = t0 % SEQ, tid = c.tid;
    for (int q = tid; q < 94 * 32; q += 512) { const int r = q >> 5, c8 = q & 31; u32x4 o = (u32x4){0u, 0u, 0u, 0u};
        if (s0 - 30 + r >= 0) { const size_t row = (size_t)(t0 - 30 + r) * NP; const u32x4 a = ldg<u32x4>(P + row + PC_CA + 8 * c8), g = ldg<u32x4>(P + row + PC_CG + 8 * c8);
#pragma unroll
            for (int e = 0; e < 4; ++e) o[e] = pk2(bflo(a[e]) * fsigmoid(bflo(g[e])), bfhi(a[e]) * fsigmoid(bfhi(g[e]))); }
        lds_st<u32x4>(c.lds + CV_U + r * 512 + c8 * 16, o); }
    wg_sync();
    { const int ch = tid & 255, half = tid >> 8; float w[31];
#pragma unroll
        for (int j = 0; j < 31; ++j) w[j] = ldg<float>(cw + j * 256 + ch);
        const float bias = ldg<float>(cb + ch);
#pragma unroll 1
        for (int sub = 0; sub < 2; ++sub) { const int tb = 32 * half + 16 * sub; float acc[16];
#pragma unroll
            for (int i = 0; i < 16; ++i) acc[i] = bias;
#pragma unroll
            for (int r = 0; r < 46; ++r) { const float u = bf2f(lds_ld<unsigned short>(c.lds + CV_U + (tb + r) * 512 + ch * 2));
#pragma unroll
                for (int i = 0; i < 16; ++i) { const int j = r - i; if (j >= 0 && j < 31) acc[i] += w[j] * u; } }
#pragma unroll
            for (int i = 0; i < 16; ++i) lds_st<float>(c.lds + CV_Y + ((tb + i) * 256 + ch) * 4, acc[i]); } }
    wg_sync();
    { const int lane = c.lane; const f32x4 lg = ldg<f32x4>(lng + 4 * lane), lb = ldg<f32x4>(lnb + 4 * lane);
#pragma unroll 2
        for (int i = 0; i < 8; ++i) { const int t = c.wave * 8 + i; const f32x4 y = lds_ld<f32x4>(c.lds + CV_Y + (t * 256 + 4 * lane) * 4);
            const float mean = wave_sum((y.x + y.y) + (y.z + y.w)) * (1.f / 256.f); const f32x4 d = y - mean;
            const float var = wave_sum((d.x * d.x + d.y * d.y) + (d.z * d.z + d.w * d.w)) * (1.f / 256.f); const float rstd = frsq(var + LN_EPS);
            f32x4 z = d * rstd * lg + lb; z.x *= fsigmoid(z.x); z.y *= fsigmoid(z.y); z.z *= fsigmoid(z.z); z.w *= fsigmoid(z.w);
            u32x2 o; o.x = pk2(z.x, z.y); o.y = pk2(z.z, z.w); stg<u32x2>(CAT + (size_t)(t0 + t) * DM + CC_CONV + 4 * lane, o); } }
    wg_sync();
}

constexpr int SW_K = 0, SW_KS = 144, SW_V = 256 * SW_KS, SW_VS = 520;
DEV void swa_item(Ctx& c, int item, const bf16_t* P, bf16_t* CAT, const float* sinks) {
    const int n = item % NBLK, kvh = (item / NBLK) & 1, b = item / (2 * NBLK), tid = c.tid, lane = c.lane;
    const long rowK0 = (long)b * SEQ + 128 * (n - 1);
    for (int q = tid; q < 2048; q += 512) { const int j = q >> 3, part = q & 7; u32x4 v = (u32x4){0u, 0u, 0u, 0u};
        if (n > 0 || j >= 128) v = ldg<u32x4>(P + (size_t)(rowK0 + j) * NP + PC_SK + 64 * kvh + 8 * part);
        lds_st<u32x4>(c.lds + SW_K + j * SW_KS + part * 16, v); }
    { const int j = tid & 255, dh = tid >> 8; const bool ok = (n > 0 || j >= 128);
#pragma unroll
        for (int q = 0; q < 4; ++q) { u32x4 v = (u32x4){0u, 0u, 0u, 0u}; if (ok) v = ldg<u32x4>(P + (size_t)(rowK0 + j) * NP + PC_SV + 64 * kvh + 32 * dh + 8 * q);
#pragma unroll
            for (int e = 0; e < 4; ++e) { const int d = 32 * dh + 8 * q + 2 * e;
                lds_st<unsigned short>(c.lds + SW_V + d * SW_VS + j * 2, (unsigned short)(v[e] & 0xffffu)); lds_st<unsigned short>(c.lds + SW_V + (d + 1) * SW_VS + j * 2, (unsigned short)(v[e] >> 16)); } } }
    wg_sync();
    const int hq = 4 * kvh + (c.wave >> 1), qh = c.wave & 1, il = lane & 31, h = lane >> 5;
    const float L2E = 1.4426950408889634f;
    const float slope2 = fexp2(-(float)(hq + 1)) * L2E, sink2 = ldg<float>(sinks + hq) * L2E, sc2 = 0.125f * L2E;
#pragma unroll 1
    for (int tq = 0; tq < 2; ++tq) {
        const int q0 = 64 * qh + 32 * tq, kt0 = q0 >> 5; const size_t qrow = (size_t)b * SEQ + 128 * n + q0 + il;
        bf16x8 Qf[4];
#pragma unroll
        for (int ks = 0; ks < 4; ++ks) Qf[ks] = ldg<bf16x8>(P + qrow * NP + PC_SQ + 64 * hq + 16 * ks + 8 * h);
        f32x16 S[5];
#pragma unroll
        for (int t = 0; t < 5; ++t) { f32x16 acc = zero16();
#pragma unroll
            for (int ks = 0; ks < 4; ++ks) { const bf16x8 A = lds_ld<bf16x8>(c.lds + SW_K + (32 * (kt0 + t) + il) * SW_KS + (16 * ks + 8 * h) * 2); acc = mfma32(A, Qf[ks], acc); }
            S[t] = acc; }
        float mx = sink2; const int iq = q0 + il;
#pragma unroll
        for (int t = 0; t < 5; ++t)
#pragma unroll
            for (int e = 0; e < 16; ++e) { const int j = 32 * (kt0 + t) + crow(e, h), dist = iq - j + 128; const bool ok = dist >= 0 && dist < 128 && (n > 0 || j >= 128);
                const float v = ok ? S[t][e] * sc2 - slope2 * (float)dist : -1e30f; S[t][e] = v; mx = fmaxf(mx, v); }
        mx = fmaxf(mx, shfl_xor_f(mx, 32)); float sum = 0.f;
#pragma unroll
        for (int t = 0; t < 5; ++t)
#pragma unroll
            for (int e = 0; e < 16; ++e) { const float p = fexp2(S[t][e] - mx); S[t][e] = p; sum += p; }
        sum += shfl_xor_f(sum, 32); sum += fexp2(sink2 - mx); const float inv = frcp(sum);
        f32x16 O[2]; O[0] = zero16(); O[1] = zero16();
#pragma unroll
        for (int t = 0; t < 5; ++t)
#pragma unroll
            for (int s = 0; s < 2; ++s) { const bf16x8 Pf = pack8(S[t], s);
#pragma unroll
                for (int V = 0; V < 2; ++V) { LAS unsigned char* vp = c.lds + SW_V + (32 * V + il) * SW_VS + (32 * (kt0 + t) + 16 * s + 4 * h) * 2;
                    const s16x4 lo = lds_ld<s16x4>(vp), hi = lds_ld<s16x4>(vp + 16); const bf16x8 A = __builtin_shufflevector(lo, hi, 0, 1, 2, 3, 4, 5, 6, 7);
                    O[V] = mfma32(A, Pf, O[V]); } }
#pragma unroll
        for (int V = 0; V < 2; ++V)
#pragma unroll
            for (int g = 0; g < 4; ++g) { u32x2 o; o.x = pk2(O[V][4 * g] * inv, O[V][4 * g + 1] * inv); o.y = pk2(O[V][4 * g + 2] * inv, O[V][4 * g + 3] * inv);
                stg<u32x2>(CAT + qrow * DM + CC_SWA + 64 * hq + 32 * V + 8 * g + 4 * h, o); }
    }
    wg_sync();
}

constexpr int GL_VS = 136, GL_VT = 64 * GL_VS  , GL_SG = 8 * GL_VT, GL_SS = 72, GL_SGW = 64 * GL_SS  ;
DEV void gla_stage_vt(LAS unsigned char* vt, const bf16_t* P, size_t row0, int head, int lane) {
#pragma unroll
    for (int q = 0; q < 8; ++q) { const u32x4 v = ldg<u32x4>(P + (row0 + lane) * NP + PC_GV + 64 * head + 8 * q);
#pragma unroll
        for (int e = 0; e < 4; ++e) { const int d = 8 * q + 2 * e; lds_st<unsigned short>(vt + d * GL_VS + lane * 2, (unsigned short)(v[e] & 0xffffu)); lds_st<unsigned short>(vt + (d + 1) * GL_VS + lane * 2, (unsigned short)(v[e] >> 16)); } }
    wave_sync();
}
DEV bf16x8 gla_vfrag(LAS unsigned char* vt, int V, int T, int s, int lane) {
    LAS unsigned char* p = vt + (32 * V + (lane & 31)) * GL_VS + (32 * T + 16 * s + 4 * (lane >> 5)) * 2;
    const s16x4 lo = lds_ld<s16x4>(p), hi = lds_ld<s16x4>(p + 16); return __builtin_shufflevector(lo, hi, 0, 1, 2, 3, 4, 5, 6, 7);
}
DEV void gla_gate(const bf16_t* P, size_t row0, int head, const float* w2, const float* gb, int lane, bf16x8 (&ghi)[2][2], bf16x8 (&glo)[2][2]) {
    const int cl = lane & 31, h = lane >> 5;
    u32x4 wb;
#pragma unroll
    for (int e = 0; e < 4; ++e) wb[e] = pk2(ldg<float>(w2 + (8 * h + 2 * e) * 128 + 32 * head + cl), ldg<float>(w2 + (8 * h + 2 * e + 1) * 128 + 32 * head + cl));
    const bf16x8 Bw = __builtin_bit_cast(bf16x8, wb); const float bias = ldg<float>(gb + 32 * head + cl);
#pragma unroll
    for (int T = 0; T < 2; ++T) { const bf16x8 A = ldg<bf16x8>(P + (row0 + 32 * T + cl) * NP + PC_GLR + 8 * h); f32x16 z = mfma32(A, Bw, zero16()); f32x16 lo;
#pragma unroll
        for (int e = 0; e < 16; ++e) { const float v = z[e] + bias; const float ls = fminf(v, 0.f) - flog2(1.0f + fexp(-fabsf(v))) * 0.6931471805599453f;
            const float g = ls * (1.0f / 16.0f); const float gh = __builtin_bit_cast(float, __builtin_bit_cast(unsigned, g) & 0xffff0000u); z[e] = gh; lo[e] = g - gh; }
#pragma unroll
        for (int s = 0; s < 2; ++s) { ghi[T][s] = pack8(z, s); glo[T][s] = pack8(lo, s); } }
}
DEV bf16x8 tri_frag(int s, int lane) {
    bf16x8 f; const int r = lane & 31, h = lane >> 5;
#pragma unroll
    for (int j = 0; j < 8; ++j) f[j] = (16 * s + 8 * (j >> 2) + 4 * h + (j & 3)) <= r ? (short)0x3F80 : (short)0;
    return f;
}
DEV bf16x8 ones_frag() { bf16x8 f; for (int j = 0; j < 8; ++j) f[j] = (short)0x3F80; return f; }

DEV void gla_m1_chunk(Ctx& c, int ci  , const bf16_t* P, float* DS, float* DD, const float* w2, const float* gb) {
    const int lane = c.lane, cl = lane & 31, h = lane >> 5, n = ci % NCH, head = (ci / NCH) & 3, b = ci / (4 * NCH); const size_t row0 = (size_t)b * SEQ + 64 * n;
    LAS unsigned char* vt = c.lds + c.wave * GL_VT;
    gla_stage_vt(vt, P, row0, head, lane);
    bf16x8 ghi[2][2], glo[2][2]; gla_gate(P, row0, head, w2, gb, lane, ghi, glo);
    f32x16 bt[2]; bt[0] = zero16(); bt[1] = zero16(); const bf16x8 ones = ones_frag();
#pragma unroll
    for (int s = 0; s < 2; ++s) { const bf16x8 tri = tri_frag(s, lane);
        bt[0] = mfma32(tri, ghi[0][s], bt[0]); bt[0] = mfma32(tri, glo[0][s], bt[0]);
        bt[1] = mfma32(ones, ghi[0][s], bt[1]); bt[1] = mfma32(ones, glo[0][s], bt[1]); bt[1] = mfma32(tri, ghi[1][s], bt[1]); bt[1] = mfma32(tri, glo[1][s], bt[1]); }
    const float blast = shfl_f(bt[1][15], 32 + cl);
    bf16x8 kh[2][2];
#pragma unroll
    for (int T = 0; T < 2; ++T) { f32x16 kk;
#pragma unroll
        for (int e = 0; e < 16; ++e) { const float kv = bf2f(ldg<unsigned short>(P + (row0 + 32 * T + crow(e, h)) * NP + PC_GK + 32 * head + cl)); kk[e] = kv * fexp(blast - bt[T][e]); }
        kh[T][0] = pack8(kk, 0); kh[T][1] = pack8(kk, 1); }
#pragma unroll
    for (int V = 0; V < 2; ++V) { f32x16 d = zero16();
#pragma unroll
        for (int T = 0; T < 2; ++T)
#pragma unroll
            for (int s = 0; s < 2; ++s) d = mfma32(kh[T][s], gla_vfrag(vt, V, T, s, lane), d);
#pragma unroll
        for (int e = 0; e < 16; ++e) stg<float>(DS + (size_t)ci * 2048 + crow(e, h) * 64 + 32 * V + cl, d[e]); }
    if (lane < 32) stg<float>(DD + (size_t)ci * 32 + cl, fexp(blast));
    wave_sync();
}
DEV void gla_m2_group(Ctx& c, int gi  , const bf16_t* P, bf16_t* CAT, const float* DS, const float* DD, const float* w2, const float* gb, const float* gng) {
    const int lane = c.lane, cl = lane & 31, h = lane >> 5, g = gi % (NCH / 8), bh = gi / (NCH / 8), head = bh & 3, b = bh >> 2;
    { const int e4 = c.tid * 4, dk = e4 >> 6, dv0 = e4 & 63; f32x4 S = (f32x4){0.f, 0.f, 0.f, 0.f}; const size_t cb = (size_t)bh * NCH;
#pragma unroll 4
        for (int m = 0; m < g * 8; ++m) { const float dd = ldg<float>(DD + (cb + m) * 32 + dk); const f32x4 ds = ldg<f32x4>(DS + (cb + m) * 2048 + e4); S = S * dd + ds; }
#pragma unroll
        for (int w = 0; w < 8; ++w) { LAS unsigned char* sg = c.lds + GL_SG + w * GL_SGW + dk * 2;
            lds_st<unsigned short>(sg + (dv0 + 0) * GL_SS, (unsigned short)(pk2(S.x, 0.f) & 0xffffu)); lds_st<unsigned short>(sg + (dv0 + 1) * GL_SS, (unsigned short)(pk2(S.y, 0.f) & 0xffffu));
            lds_st<unsigned short>(sg + (dv0 + 2) * GL_SS, (unsigned short)(pk2(S.z, 0.f) & 0xffffu)); lds_st<unsigned short>(sg + (dv0 + 3) * GL_SS, (unsigned short)(pk2(S.w, 0.f) & 0xffffu));
            if (w < 7) { const int m = g * 8 + w; const float dd = ldg<float>(DD + (cb + m) * 32 + dk); const f32x4 ds = ldg<f32x4>(DS + (cb + m) * 2048 + e4); S = S * dd + ds; } } }
    const int n = g * 8 + c.wave; const size_t row0 = (size_t)b * SEQ + 64 * n;
    LAS unsigned char* vt = c.lds + c.wave * GL_VT; LAS unsigned char* sg = c.lds + GL_SG + c.wave * GL_SGW;
    gla_stage_vt(vt, P, row0, head, lane);
    wg_sync();
    bf16x8 ghi[2][2], glo[2][2]; gla_gate(P, row0, head, w2, gb, lane, ghi, glo);
    f32x16 bT[2]; bT[0] = zero16(); bT[1] = zero16(); const bf16x8 ones = ones_frag();
#pragma unroll
    for (int s = 0; s < 2; ++s) { const bf16x8 tri = tri_frag(s, lane);
        bT[0] = mfma32(ghi[0][s], tri, bT[0]); bT[0] = mfma32(glo[0][s], tri, bT[0]);
        bT[1] = mfma32(ghi[0][s], ones, bT[1]); bT[1] = mfma32(glo[0][s], ones, bT[1]); bT[1] = mfma32(ghi[1][s], tri, bT[1]); bT[1] = mfma32(glo[1][s], tri, bT[1]); }
    bf16x8 qf[2][2], kf[2][2];
    const float qscale = 0.17677669529663687f;
#pragma unroll
    for (int T = 0; T < 2; ++T)
#pragma unroll
        for (int s = 0; s < 2; ++s) { const bf16_t* qp = P + (row0 + 32 * T + cl) * NP + PC_GQ + 32 * head + 16 * s + 4 * h; const bf16_t* kp = qp + (PC_GK - PC_GQ);
            const u32x2 q0 = ldg<u32x2>(qp), q1 = ldg<u32x2>(qp + 8), k0 = ldg<u32x2>(kp), k1 = ldg<u32x2>(kp + 8);
            float eb[8];
#pragma unroll
            for (int j = 0; j < 8; ++j) eb[j] = bT[T][8 * s + j] * 1.4426950408889634f;
            u32x4 qo, ko;
            qo.x = pk2(bflo(q0.x) * fexp2(eb[0]) * qscale, bfhi(q0.x) * fexp2(eb[1]) * qscale); qo.y = pk2(bflo(q0.y) * fexp2(eb[2]) * qscale, bfhi(q0.y) * fexp2(eb[3]) * qscale);
            qo.z = pk2(bflo(q1.x) * fexp2(eb[4]) * qscale, bfhi(q1.x) * fexp2(eb[5]) * qscale); qo.w = pk2(bflo(q1.y) * fexp2(eb[6]) * qscale, bfhi(q1.y) * fexp2(eb[7]) * qscale);
            ko.x = pk2(bflo(k0.x) * fexp2(-eb[0]), bfhi(k0.x) * fexp2(-eb[1])); ko.y = pk2(bflo(k0.y) * fexp2(-eb[2]), bfhi(k0.y) * fexp2(-eb[3]));
            ko.z = pk2(bflo(k1.x) * fexp2(-eb[4]), bfhi(k1.x) * fexp2(-eb[5])); ko.w = pk2(bflo(k1.y) * fexp2(-eb[6]), bfhi(k1.y) * fexp2(-eb[7]));
            qf[T][s] = __builtin_bit_cast(bf16x8, qo); kf[T][s] = __builtin_bit_cast(bf16x8, ko); }
#pragma unroll
    for (int Ti = 0; Ti < 2; ++Ti) {
        f32x16 o[2]; o[0] = zero16(); o[1] = zero16();
#pragma unroll
        for (int V = 0; V < 2; ++V)
#pragma unroll
            for (int s = 0; s < 2; ++s) { LAS unsigned char* p = sg + (32 * V + cl) * GL_SS + (16 * s + 4 * h) * 2; const s16x4 lo = lds_ld<s16x4>(p), hi = lds_ld<s16x4>(p + 16);
                o[V] = mfma32(__builtin_shufflevector(lo, hi, 0, 1, 2, 3, 4, 5, 6, 7), qf[Ti][s], o[V]); }
#pragma unroll
        for (int Tj = 0; Tj <= Ti; ++Tj) { f32x16 a = zero16();
#pragma unroll
            for (int s = 0; s < 2; ++s) a = mfma32(kf[Tj][s], qf[Ti][s], a);
            if (Tj == Ti) {
#pragma unroll
                for (int e = 0; e < 16; ++e) a[e] = crow(e, h) <= cl ? a[e] : 0.f; }
#pragma unroll
            for (int s = 0; s < 2; ++s) { const bf16x8 pf = pack8(a, s);
#pragma unroll
                for (int V = 0; V < 2; ++V) o[V] = mfma32(gla_vfrag(vt, V, Tj, s, lane), pf, o[V]); } }
        float ss = 0.f;
#pragma unroll
        for (int V = 0; V < 2; ++V)
#pragma unroll
            for (int e = 0; e < 16; ++e) ss += o[V][e] * o[V][e];
        ss += shfl_xor_f(ss, 32); const float rstd = frsq(ss * (1.f / 64.f) + RMS_EPS); const size_t row = row0 + 32 * Ti + cl;
#pragma unroll
        for (int V = 0; V < 2; ++V)
#pragma unroll
            for (int g4 = 0; g4 < 4; ++g4) { const int dv0 = 32 * V + 8 * g4 + 4 * h; const u32x2 rr = ldg<u32x2>(P + row * NP + PC_GR + 64 * head + dv0); const f32x4 gn = ldg<f32x4>(gng + 64 * head + dv0);
                const float r0 = bflo(rr.x), r1 = bfhi(rr.x), r2 = bflo(rr.y), r3 = bfhi(rr.y);
                u32x2 w; w.x = pk2(o[V][4 * g4] * rstd * gn.x * r0 * fsigmoid(r0), o[V][4 * g4 + 1] * rstd * gn.y * r1 * fsigmoid(r1));
                w.y = pk2(o[V][4 * g4 + 2] * rstd * gn.z * r2 * fsigmoid(r2), o[V][4 * g4 + 3] * rstd * gn.w * r3 * fsigmoid(r3));
                stg<u32x2>(CAT + row * DM + CC_GLA + 64 * head + dv0, w); }
    }
    wg_sync();
}

struct LayerP { const float *w2, *gb, *gng, *cw, *cb, *clg, *clb, *sinks; };
DEV void mixer_m1(Ctx& c, const Bufs& B, const LayerP& L) {
#ifndef SKIP_SWA
    for (int it = c.bid; it < NBATCH * 2 * NBLK; it += c.G) swa_item(c, it, B.P, B.CAT, L.sinks);
#endif
#ifndef SKIP_CONV
    for (int it = c.bid; it < M / CV_T; it += c.G) conv_item(c, it, B.P, B.CAT, L.cw, L.cb, L.clg, L.clb);
#endif
#ifndef SKIP_GLA1
    for (int it = c.bid; it < NBATCH * 4 * NCH / 8; it += c.G) gla_m1_chunk(c, it * 8 + c.wave, B.P, B.DS, B.DD, L.w2, L.gb);
#endif
}
DEV void mixer_m2(Ctx& c, const Bufs& B, const LayerP& L) {
#ifndef SKIP_GLA2
    for (int it = c.bid; it < NBATCH * 4 * NCH / 8; it += c.G) gla_m2_group(c, it, B.P, B.CAT, B.DS, B.DD, L.w2, L.gb, L.gng);
#endif
}

struct GUnit { int pm, pn; };
struct EpiStore {
    static constexpr bool PERM = true, AFTER_DRAIN = false;
    bf16_t* O; int ldc;
    DEV void operator()(const f32x4 (&acc)[2][2][4][2], int pm, int pn, int wr, int wc, int fr, int fq) const {
        const int row0 = pm * 256 + wr * 64 + fr, col0 = pn * 256 + wc * 32 + 8 * fq;
#pragma unroll
        for (int ai = 0; ai < 2; ++ai)
#pragma unroll
            for (int m = 0; m < 4; ++m) { bf16_t* rowp = O + (size_t)(row0 + ai * 128 + m * 16) * ldc + col0;
#pragma unroll
                for (int bj = 0; bj < 2; ++bj) { const f32x4 v0 = acc[ai][bj][m][0], v1 = acc[ai][bj][m][1];
                    u32x4 w; w.x = pk2(v0[0], v0[1]); w.y = pk2(v0[2], v0[3]); w.z = pk2(v1[0], v1[1]); w.w = pk2(v1[2], v1[3]); stg<u32x4>(rowp + bj * 128, w); } }
    }
};
struct EpiSwiGLU {
    static constexpr bool PERM = true, AFTER_DRAIN = false;
    bf16_t* O; int ldc;
    DEV void operator()(const f32x4 (&acc)[2][2][4][2], int pm, int pn, int wr, int wc, int fr, int fq) const {
        const int row0 = pm * 256 + wr * 64 + fr, col0 = pn * 128 + wc * 32 + 8 * fq;
#pragma unroll
        for (int ai = 0; ai < 2; ++ai)
#pragma unroll
            for (int m = 0; m < 4; ++m) { float r[8];
#pragma unroll
                for (int n = 0; n < 2; ++n)
#pragma unroll
                    for (int e = 0; e < 4; ++e) { const float g = acc[ai][0][m][n][e], u = acc[ai][1][m][n][e]; r[4 * n + e] = g * fsigmoid(g) * u; }
                u32x4 w; w.x = pk2(r[0], r[1]); w.y = pk2(r[2], r[3]); w.z = pk2(r[4], r[5]); w.w = pk2(r[6], r[7]);
                stg<u32x4>(O + (size_t)(row0 + ai * 128 + m * 16) * ldc + col0, w); }
    }
};

#ifndef HOST_EMU
namespace pg8 {
constexpr int BM = 256, BK = 64, HALF = 128, HTB = HALF * BK * 2  , STAGE_BYTES = 8 * HTB, NXCD = 8, WGM = 8;
__device__ __forceinline__ int lds_byte(int r, int c) { const int st = (r >> 4) * 2 + (c >> 5), rr = r & 15, cc = c & 31, ob = rr * 64 + cc * 2; return st * 1024 + (ob ^ (((ob >> 9) & 1) << 5)); }
__device__ __forceinline__ void stage_rc(int b, int& R, int& C) { const int st = b / 1024, sb = b % 1024, swz = sb ^ (((sb >> 9) & 1) << 5); R = (st >> 1) * 16 + swz / 64; C = (st & 1) * 32 + (swz % 64) / 2; }
__device__ __forceinline__ int perm32(int rho) { const int n = rho >> 4, i = rho & 15; return 8 * (i >> 2) + 4 * n + (i & 3); }
struct Unit { int pm, pn; };
struct Gemm { const bf16_t* A; const bf16_t* Bt; int M, N, K; };
struct StaticOrder {
    int nM, nN, nwg, G, c;
    __device__ void init(int M_, int N_, int G_, int c_) { nM = M_ / BM; nN = N_ / BM; nwg = nM * nN; G = G_; c = c_; }
    __device__ bool next(int i, Unit& u) const {
        const long L = (long)i * G + c; if (L >= nwg) return false;
        int wgid = (int)L; { const int q = nwg / NXCD, r = nwg % NXCD, xcd = wgid % NXCD, off = wgid / NXCD; wgid = (xcd < r ? xcd * (q + 1) : r * (q + 1) + (xcd - r) * q) + off; }
        const int nig = WGM * nN, gid = wgid / nig, fm = gid * WGM, gsz = (nM - fm) < WGM ? (nM - fm) : WGM;
        u.pm = fm + ((wgid % nig) % gsz); u.pn = (wgid % nig) / gsz; return true;
    }
};
#define PG8_LAS __attribute__((address_space(3)))
template <class Epi, class Sched, bool ALIGN_EPI, bool SP2>
__device__ __forceinline__ void gemm_phase(PG8_LAS unsigned char* lds, const Gemm g, const Sched& S, const Epi& E) {
    int tid_ = threadIdx.x; asm volatile("" : "+v"(tid_));
    const int tid = tid_, wid = __builtin_amdgcn_readfirstlane(tid >> 6), lane = tid & 63, wr = wid >> 2, wc = wid & 3, fr = lane & 15, fq = lane >> 4;
    const int K = g.K, nt = K / BK;
    unsigned voffA[2], voffB[2];
#pragma unroll
    for (int i = 0; i < 2; ++i) { int R, C; stage_rc(tid * 16 + i * 8192, R, C); const int Rb = Epi::PERM ? ((R & ~31) + perm32(R & 31)) : R;
        voffA[i] = (unsigned)(R * K + C) * 2u; voffB[i] = (unsigned)(Rb * K + C) * 2u; }
    const size_t kstep = (size_t)(BK * 2);
    const size_t hstep = (size_t)HALF * K * 2;
    const size_t tstep = 2 * hstep;
    const unsigned ldsw = (unsigned)wid * 1024u;
    const int aoff = lds_byte(wr * 64 + fr, fq * 8), boff = lds_byte(wc * 32 + fr, fq * 8);
#define PG8_SA(b, h) (((b) * 2 + (h)) * HTB)
#define PG8_SB(b, h) ((4 + (b) * 2 + (h)) * HTB)
#define PG8_STAGE(bufoff, gbase, voff) do { _Pragma("unroll") for (int _i = 0; _i < 2; ++_i) \
        __builtin_amdgcn_global_load_lds((const unsigned*)((const char*)(gbase) + (voff)[_i]), (PG8_LAS unsigned*)(lds + (bufoff) + ldsw + _i * 8192), 16, 0, 0); } while (0)
#define PG8_LDA(dst, b, h) do { _Pragma("unroll") for (int m = 0; m < 4; ++m) _Pragma("unroll") for (int k = 0; k < 2; ++k) dst[m][k] = *(const PG8_LAS bf16x8*)(lds + PG8_SA(b, h) + aoff + m * 2048 + k * 1024); } while (0)
#define PG8_LDB(dst, b, h) do { _Pragma("unroll") for (int n = 0; n < 2; ++n) _Pragma("unroll") for (int k = 0; k < 2; ++k) dst[n][k] = *(const PG8_LAS bf16x8*)(lds + PG8_SB(b, h) + boff + n * 2048 + k * 1024); } while (0)
#define PG8_MMA(ai, bj, At, Bt) do { __builtin_amdgcn_s_setprio(1); _Pragma("unroll") for (int m = 0; m < 4; ++m) _Pragma("unroll") for (int n = 0; n < 2; ++n) _Pragma("unroll") for (int k = 0; k < 2; ++k) \
        acc[ai][bj][m][n] = __builtin_amdgcn_mfma_f32_16x16x32_bf16(Bt[n][k], At[m][k], acc[ai][bj][m][n], 0, 0, 0); __builtin_amdgcn_s_setprio(0); } while (0)
#define PG8_WAIT_V(n) asm volatile("s_waitcnt vmcnt(" #n ")" ::: "memory")
#define PG8_WAIT_L(n) asm volatile("s_waitcnt lgkmcnt(" #n ")" ::: "memory")
#define PG8_BAR __builtin_amdgcn_s_barrier()
#define PG8_SCHED __builtin_amdgcn_sched_barrier(0)
    Unit cur, nxt; int ui = 0;
    if (!S.next(0, cur)) return;
    f32x4 acc[2][2][4][2];
#pragma unroll
    for (int a = 0; a < 2; ++a)
#pragma unroll
        for (int b = 0; b < 2; ++b)
#pragma unroll
            for (int m = 0; m < 4; ++m)
#pragma unroll
                for (int n = 0; n < 2; ++n) acc[a][b][m][n] = (f32x4){0.f, 0.f, 0.f, 0.f};
    bf16x8 At[4][2], B0[2][2], B1[2][2];
    const char* cA = (const char*)g.A + (size_t)cur.pm * tstep; const char* cB = (const char*)g.Bt + (size_t)cur.pn * tstep;
    if constexpr (SP2) {
        PG8_STAGE(PG8_SB(0, 0), cB, voffB); PG8_STAGE(PG8_SB(0, 1), cB + hstep, voffB); PG8_STAGE(PG8_SA(0, 0), cA, voffA); PG8_STAGE(PG8_SA(0, 1), cA + hstep, voffA);
        if (wr == 1) PG8_BAR;
        PG8_WAIT_V(2); PG8_BAR;
        PG8_STAGE(PG8_SB(1, 0), cB + kstep, voffB); PG8_STAGE(PG8_SA(1, 0), cA + kstep, voffA); PG8_STAGE(PG8_SB(1, 1), cB + hstep + kstep, voffB);
        PG8_WAIT_V(6); PG8_BAR;
    } else {
        PG8_STAGE(PG8_SB(0, 0), cB, voffB); PG8_STAGE(PG8_SA(0, 0), cA, voffA); PG8_STAGE(PG8_SB(0, 1), cB + hstep, voffB); PG8_STAGE(PG8_SA(0, 1), cA + hstep, voffA);
        if (wr == 1) PG8_BAR;
        PG8_WAIT_V(4); PG8_BAR;
        PG8_STAGE(PG8_SB(1, 0), cB + kstep, voffB); PG8_STAGE(PG8_SA(1, 0), cA + kstep, voffA); PG8_STAGE(PG8_SB(1, 1), cB + hstep + kstep, voffB);
        PG8_WAIT_V(6); PG8_BAR;
    }
    for (;;) {
        const bool has_next = S.next(ui + 1, nxt);
        const char* nA = has_next ? (const char*)g.A + (size_t)nxt.pm * tstep : cA; const char* nB = has_next ? (const char*)g.Bt + (size_t)nxt.pn * tstep : cB;
        for (int t = 0; t < nt; t += 2) {
            const bool last = (t == nt - 2);
            const char* a1 = cA + (size_t)(t + 1) * kstep;
            const char* a2 = last ? nA : cA + (size_t)(t + 2) * kstep; const char* b2 = last ? nB : cB + (size_t)(t + 2) * kstep;
            const char* a3 = a2 + kstep; const char* b3 = b2 + kstep;
            if constexpr (SP2) {
            PG8_LDB(B0, 0, 0); PG8_LDB(B1, 0, 1); PG8_SCHED; PG8_LDA(At, 0, 0); PG8_STAGE(PG8_SA(1, 1), a1 + hstep, voffA);
            PG8_WAIT_V(8); PG8_WAIT_L(0); PG8_BAR; PG8_MMA(0, 0, At, B0); PG8_MMA(0, 1, At, B1); PG8_BAR; PG8_SCHED;
            PG8_LDA(At, 0, 1); PG8_STAGE(PG8_SB(0, 0), b2, voffB); PG8_STAGE(PG8_SB(0, 1), b2 + hstep, voffB); PG8_STAGE(PG8_SA(0, 0), a2, voffA);
            PG8_WAIT_V(8); PG8_WAIT_L(0); PG8_BAR; PG8_MMA(1, 0, At, B0); PG8_MMA(1, 1, At, B1); PG8_BAR; PG8_SCHED;
            PG8_LDB(B0, 1, 0); PG8_LDB(B1, 1, 1); PG8_SCHED; PG8_LDA(At, 1, 0); PG8_STAGE(PG8_SA(0, 1), a2 + hstep, voffA);
            PG8_WAIT_V(8); PG8_WAIT_L(0); PG8_BAR; PG8_MMA(0, 0, At, B0); PG8_MMA(0, 1, At, B1); PG8_BAR; PG8_SCHED;
            PG8_LDA(At, 1, 1); PG8_STAGE(PG8_SB(1, 0), b3, voffB); PG8_STAGE(PG8_SB(1, 1), b3 + hstep, voffB); PG8_STAGE(PG8_SA(1, 0), a3, voffA);
            PG8_WAIT_V(8); PG8_WAIT_L(0); PG8_BAR; PG8_MMA(1, 0, At, B0); PG8_MMA(1, 1, At, B1); PG8_BAR; PG8_SCHED;
            } else {
            PG8_LDB(B0, 0, 0); PG8_SCHED; PG8_LDA(At, 0, 0); PG8_STAGE(PG8_SA(1, 1), a1 + hstep, voffA);
            PG8_WAIT_L(8); PG8_BAR; PG8_WAIT_L(0); PG8_MMA(0, 0, At, B0); PG8_BAR; PG8_SCHED;
            PG8_LDB(B1, 0, 1); PG8_STAGE(PG8_SB(0, 0), b2, voffB);
            PG8_BAR; PG8_WAIT_L(0); PG8_MMA(0, 1, At, B1); PG8_BAR;
            PG8_LDA(At, 0, 1); PG8_STAGE(PG8_SA(0, 0), a2, voffA);
            PG8_BAR; PG8_WAIT_L(0); PG8_MMA(1, 0, At, B0); PG8_BAR; PG8_SCHED;
            PG8_STAGE(PG8_SB(0, 1), b2 + hstep, voffB);
            PG8_WAIT_V(6); PG8_BAR; PG8_MMA(1, 1, At, B1); PG8_BAR;
            PG8_LDB(B0, 1, 0); PG8_SCHED; PG8_LDA(At, 1, 0); PG8_STAGE(PG8_SA(0, 1), a2 + hstep, voffA);
            PG8_WAIT_L(8); PG8_BAR; PG8_WAIT_L(0); PG8_MMA(0, 0, At, B0); PG8_BAR; PG8_SCHED;
            PG8_LDB(B1, 1, 1); PG8_STAGE(PG8_SB(1, 0), b3, voffB);
            PG8_BAR; PG8_WAIT_L(0); PG8_MMA(0, 1, At, B1); PG8_BAR;
            PG8_LDA(At, 1, 1); PG8_STAGE(PG8_SA(1, 0), a3, voffA);
            PG8_BAR; PG8_WAIT_L(0); PG8_MMA(1, 0, At, B0); PG8_BAR; PG8_SCHED;
            PG8_STAGE(PG8_SB(1, 1), b3 + hstep, voffB);
            PG8_WAIT_V(6); PG8_BAR; PG8_MMA(1, 1, At, B1); PG8_BAR;
            }
        }
        if constexpr (ALIGN_EPI) { if (wr == 0) PG8_BAR; }
        E(acc, cur.pm, cur.pn, wr, wc, fr, fq);
        if (!has_next) break;
#pragma unroll
        for (int a = 0; a < 2; ++a)
#pragma unroll
            for (int b = 0; b < 2; ++b)
#pragma unroll
                for (int m = 0; m < 4; ++m)
#pragma unroll
                    for (int n = 0; n < 2; ++n) acc[a][b][m][n] = (f32x4){0.f, 0.f, 0.f, 0.f};
        cur = nxt; cA = nA; cB = nB; ++ui;
        if constexpr (ALIGN_EPI) { if (wr == 1) PG8_BAR; }
    }
    PG8_WAIT_V(0);
    if constexpr (!ALIGN_EPI) { if (wr == 0) PG8_BAR; }
    PG8_BAR;
#undef PG8_SA
#undef PG8_SB
#undef PG8_STAGE
#undef PG8_LDA
#undef PG8_LDB
#undef PG8_MMA
#undef PG8_WAIT_V
#undef PG8_WAIT_L
#undef PG8_BAR
#undef PG8_SCHED
}
}

#define XB_TMO      128
#define XB_XCNT(j)  (256  + 64 * (j))
#define XB_XSUB(j)  (1280 + 64 * (j))
#define XB_XGEN(j)  (2304 + 64 * (j))
#define XB_TOP      3328
#define XB_TOPGEN   3392
#define XCD_BAR_WORDS 3456
#define XB_SPIN_CAP (1u << 18)
__device__ __forceinline__ unsigned xb_ld(unsigned* p)              { return __hip_atomic_load(p, __ATOMIC_RELAXED, __HIP_MEMORY_SCOPE_AGENT); }
__device__ __forceinline__ unsigned xb_add(unsigned* p, unsigned v) { return __hip_atomic_fetch_add(p, v, __ATOMIC_RELAXED, __HIP_MEMORY_SCOPE_AGENT); }
__device__ __forceinline__ unsigned xb_xcc_id() { return (unsigned)__builtin_amdgcn_s_getreg((3 << 11) | 20) & 0xFu; }
#define XB_SPIN(cond, bar) do { unsigned _sp = 0; while (cond) { __builtin_amdgcn_s_sleep(1); \
    if ((++_sp & 255u) == 0u) { if (xb_ld(&(bar)[XB_TMO])) break; if (_sp > XB_SPIN_CAP) { atomicAdd(&(bar)[XB_TMO], 1u); break; } } } } while (0)
struct XcdBarrier {
    unsigned* bar; unsigned x;
    volatile LAS unsigned* st;
};
__device__ __forceinline__ XcdBarrier xcd_barrier_post(unsigned* bar, volatile LAS unsigned* st) {
    XcdBarrier b; b.bar = bar; b.x = xb_xcc_id(); b.st = st;
    if (threadIdx.x == 0) (void)xb_add(&bar[XB_XCNT(b.x)], 1u);
    return b;
}
__device__ __forceinline__ void xcd_barrier_complete(unsigned* bar, unsigned x, unsigned& nloc, unsigned& nx) {
    const unsigned G = gridDim.x * gridDim.y * gridDim.z;
    unsigned sum, cnt, mine, sp = 0u;
    for (;;) {
        sum = 0u; cnt = 0u; mine = 0u;
#pragma unroll
        for (unsigned j = 0; j < 16; ++j) { const unsigned c = xb_ld(&bar[XB_XCNT(j)]); sum += c; cnt += (c > 0u) ? 1u : 0u; mine = (j == x) ? c : mine; }
        if (sum == G) break;
        __builtin_amdgcn_s_sleep(1);
        if ((++sp & 255u) == 0u) { if (xb_ld(&bar[XB_TMO])) break; if (sp > XB_SPIN_CAP) { atomicAdd(&bar[XB_TMO], 1u); break; } }
    }
    nloc = mine > 0u ? mine : 1u; nx = cnt > 0u ? cnt : 1u;
}
__device__ __forceinline__ void xcd_barrier(const XcdBarrier& b) {
    asm volatile("s_waitcnt vmcnt(0)" ::: "memory");
    __syncthreads();
    if (threadIdx.x == 0) {
        unsigned* bar = b.bar;
        __builtin_amdgcn_s_waitcnt(0);
        unsigned nloc = b.st[0], nx = b.st[1];
        if (nloc == 0u) { xcd_barrier_complete(bar, b.x, nloc, nx); b.st[0] = nloc; b.st[1] = nx; }
        const unsigned old = xb_add(&bar[XB_XSUB(b.x)], 1u);
        const unsigned gen = old / nloc;
        if (old + 1u == (gen + 1u) * nloc) {
            __builtin_amdgcn_fence(__ATOMIC_RELEASE, "agent");
            asm volatile("s_waitcnt vmcnt(0)" ::: "memory");
            const unsigned og = xb_add(&bar[XB_TOP], 1u);
            const unsigned tg = og / nx;
            if (og + 1u == (tg + 1u) * nx) xb_add(&bar[XB_TOPGEN], 1u);
            else XB_SPIN(xb_ld(&bar[XB_TOPGEN]) == tg, bar);
            __builtin_amdgcn_fence(__ATOMIC_ACQUIRE, "agent");
            xb_add(&bar[XB_XGEN(b.x)], 1u);
            asm volatile("s_waitcnt vmcnt(0)" ::: "memory");
        } else {
            XB_SPIN(xb_ld(&bar[XB_XGEN(b.x)]) == gen, bar);
            __builtin_amdgcn_fence(__ATOMIC_ACQUIRE, "agent");
            asm volatile("s_waitcnt vmcnt(0)" ::: "memory");
        }
    }
    __syncthreads();
}

constexpr size_t MiB = 1u << 20;
constexpr size_t al(size_t x) { return (x + MiB - 1) / MiB * MiB; }
constexpr size_t WS_CTL = 0, CTL_ZERO_BYTES = 1 * MiB;
constexpr size_t WS_WGU = WS_CTL + CTL_ZERO_BYTES, SZ_WGU = (size_t)4 * NGU * DM * 2;
constexpr size_t WS_WD = al(WS_WGU + SZ_WGU), SZ_WD = (size_t)4 * DM * DFF * 2;
constexpr size_t WS_WIN = al(WS_WD + SZ_WD), SZ_WIN = (size_t)2 * NP * DM * 2;
constexpr size_t WS_WOUT = al(WS_WIN + SZ_WIN), SZ_WOUT = (size_t)2 * DM * DM * 2;
constexpr size_t WS_XN = al(WS_WOUT + SZ_WOUT), SZ_XN = (size_t)M * DM * 2;
constexpr size_t WS_H = al(WS_XN + SZ_XN), SZ_H = (size_t)M * DM * 2;
constexpr size_t WS_ACT = al(WS_H + SZ_H), SZ_ACT = (size_t)M * DFF * 2;
constexpr size_t WS_CAT = al(WS_ACT + SZ_ACT), SZ_CAT = (size_t)M * DM * 2;
constexpr size_t WS_DS = al(WS_CAT + SZ_CAT), SZ_DS = (size_t)NBATCH * 4 * NCH * 2048 * 4;
constexpr size_t WS_DD = al(WS_DS + SZ_DS), SZ_DD = (size_t)NBATCH * 4 * NCH * 32 * 4;
constexpr size_t WS_END = al(WS_DD + SZ_DD);
static_assert((size_t)M * NP * 2 <= SZ_ACT, "P overlays ACT");
constexpr int CW_BAR = 4096;
static_assert((CW_BAR + XCD_BAR_WORDS) * 4 <= (int)CTL_ZERO_BYTES, "control words");

constexpr int RING_BYTES = 131072, MISC_OFF = RING_BYTES + 320, LDS_BYTES = 147456;

struct Args { const float* in[15]; float* out; unsigned char* ws; int ph_lo, ph_hi; };

__device__ __forceinline__ bool relaunder(Ctx& c) { int t = threadIdx.x; asm volatile("" : "+v"(t)); c.tid = t; c.lane = t & 63; c.wave = __builtin_amdgcn_readfirstlane(t >> 6); return true; }
__global__ void __launch_bounds__(512, 2) fwd_kernel(Args args) {
    extern __shared__ __attribute__((aligned(16))) unsigned char lds_raw[];
    Ctx c; c.lds = (LAS unsigned char*)lds_raw; c.tid = threadIdx.x; c.lane = c.tid & 63; c.wave = __builtin_amdgcn_readfirstlane(c.tid >> 6);
    c.G = gridDim.x; { const int bx = blockIdx.x; c.bid = (c.G % 8 == 0) ? (bx % 8) * (c.G / 8) + bx / 8 : bx; }
    volatile LAS unsigned* MISC = (volatile LAS unsigned*)(c.lds + MISC_OFF);
    for (int u = c.tid; u < (LDS_BYTES - RING_BYTES) / 4; u += 512) ((LAS unsigned*)(c.lds + RING_BYTES))[u] = 0u;
    __syncthreads();
    unsigned char* ws = args.ws;
    XcdBarrier bar = xcd_barrier_post((unsigned*)(ws + WS_CTL) + CW_BAR, MISC + 8);
    Inputs in; in.x = args.in[0]; in.norm_g = args.in[1]; in.wg = args.in[2]; in.wu = args.in[3]; in.wd = args.in[4]; in.win = args.in[5]; in.gw2 = args.in[6]; in.gb = args.in[7];
    in.gng = args.in[8]; in.cw = args.in[9]; in.cb = args.in[10]; in.clg = args.in[11]; in.clb = args.in[12]; in.sinks = args.in[13]; in.wout = args.in[14];
    Bufs B; B.Wgu = (bf16_t*)(ws + WS_WGU); B.Wd = (bf16_t*)(ws + WS_WD); B.Win = (bf16_t*)(ws + WS_WIN); B.Wout = (bf16_t*)(ws + WS_WOUT); B.XN = (bf16_t*)(ws + WS_XN); B.H = (bf16_t*)(ws + WS_H);
    B.ACT = (bf16_t*)(ws + WS_ACT); B.P = (bf16_t*)(ws + WS_ACT); B.CAT = (bf16_t*)(ws + WS_CAT); B.DS = (float*)(ws + WS_DS); B.DD = (float*)(ws + WS_DD); B.X = args.out;
    const int lo = args.ph_lo, hi = args.ph_hi; int ph = 0;
#define RUN() (ph >= lo && ph < hi && relaunder(c))
#ifndef PROBE_DUP
#define PROBE_DUP 0
#endif
#define DUP(bit) for (int dup_ = 0; dup_ < (((PROBE_DUP) >> (bit)) & 1) + 1; ++dup_, (dup_ < (((PROBE_DUP) >> (bit)) & 1) + 1 ? xcd_barrier(bar) : (void)0))
#define SEAM() do { if (ph >= lo && ph + 1 < hi) xcd_barrier(bar); ++ph; } while (0)
    DUP(0) if (RUN()) prologue_phase(c, in, B);
    SEAM();
#pragma unroll 1
    for (int step = 0; step < 2 * DEPTH; ++step) {
        const int l = step >> 1, f = step & 1;
        DUP(1) if (RUN()) { pg8::Gemm g{B.XN, B.Wgu + (size_t)step * NGU * DM, M, NGU, DM}; pg8::StaticOrder S; S.init(M, NGU, c.G, (int)blockIdx.x);
            EpiSwiGLU E{B.ACT, DFF}; pg8::gemm_phase<EpiSwiGLU, pg8::StaticOrder, true, true>(c.lds, g, S, E); }
        SEAM();
        DUP(2) if (RUN()) { pg8::Gemm g{B.ACT, B.Wd + (size_t)step * DM * DFF, M, DM, DFF}; pg8::StaticOrder S; S.init(M, DM, c.G, (int)blockIdx.x);
            EpiStore E{B.H, DM}; pg8::gemm_phase<EpiStore, pg8::StaticOrder, true, true>(c.lds, g, S, E); }
        SEAM();
        if ((PROBE_DUP >> 3) & 1) { if (RUN()) thin_phase(c, B.H, step == 0 ? in.x : B.X, (float*)B.ACT, B.CAT, in.norm_g + (l * 6 + (f ? 5 : 1)) * DM, 0.5f, step != 2 * DEPTH - 1); xcd_barrier(bar); }
        if (RUN()) thin_phase(c, B.H, step == 0 ? in.x : B.X, B.X, B.XN, in.norm_g + (l * 6 + (f ? 5 : 1)) * DM, 0.5f, step != 2 * DEPTH - 1);
        SEAM();
        if (f == 0) {
            LayerP L; L.w2 = in.gw2 + l * 16 * 128; L.gb = in.gb + l * 128; L.gng = in.gng + l * 256; L.cw = in.cw + l * 31 * 256; L.cb = in.cb + l * 256; L.clg = in.clg + l * 256; L.clb = in.clb + l * 256; L.sinks = in.sinks + l * 8;
            DUP(4) if (RUN()) { pg8::Gemm g{B.XN, B.Win + (size_t)l * NP * DM, M, NP, DM}; pg8::StaticOrder S; S.init(M, NP, c.G, (int)blockIdx.x);
                EpiStore E{B.P, NP}; pg8::gemm_phase<EpiStore, pg8::StaticOrder, true, true>(c.lds, g, S, E); }
            SEAM();
            DUP(5) if (RUN()) mixer_m1(c, B, L);
            SEAM();
            DUP(6) if (RUN()) mixer_m2(c, B, L);
            SEAM();
            DUP(7) if (RUN()) { pg8::Gemm g{B.CAT, B.Wout + (size_t)l * DM * DM, M, DM, DM}; pg8::StaticOrder S; S.init(M, DM, c.G, (int)blockIdx.x);
                EpiStore E{B.H, DM}; pg8::gemm_phase<EpiStore, pg8::StaticOrder, true, true>(c.lds, g, S, E); }
            SEAM();
            if (RUN()) thin_phase(c, B.H, B.X, B.X, B.XN, in.norm_g + (l * 6 + 3) * DM, 1.0f, true);
            SEAM();
        }
    }
#undef RUN
#undef SEAM
}

constexpr int N_PHASES = 1 + 4 * 3 + 2 * 5;
#ifndef MK_N_LAUNCHES
#define MK_N_LAUNCHES 1
#endif
extern "C" void kernel_launch(void* const* d_in, const int* in_sizes, int n_in, void* d_out, int out_size, void* d_ws, size_t ws_size, hipStream_t stream) {
    static int grid = 0;
    if (grid == 0) {
        if (n_in != 15 || in_sizes[0] != M * DM || out_size != M * DM || ws_size < WS_END) { fprintf(stderr, "kernel_launch: unexpected shapes (n_in %d, in0 %d, out %d, ws %zu < %zu); nothing launched\n", n_in, n_in > 0 ? in_sizes[0] : -1, out_size, ws_size, (size_t)WS_END); grid = -1; return; }
        int dev = 0, cus = 0, per_cu = 0;
        if (hipGetDevice(&dev) != hipSuccess || hipDeviceGetAttribute(&cus, hipDeviceAttributeMultiprocessorCount, dev) != hipSuccess) { grid = -1; return; }
        if (hipFuncSetAttribute((const void*)fwd_kernel, hipFuncAttributeMaxDynamicSharedMemorySize, LDS_BYTES) != hipSuccess) { fprintf(stderr, "kernel_launch: hipFuncSetAttribute failed\n"); grid = -1; return; }
        if (hipOccupancyMaxActiveBlocksPerMultiprocessor(&per_cu, (const void*)fwd_kernel, 512, LDS_BYTES) != hipSuccess || per_cu < 1) { fprintf(stderr, "kernel_launch: occupancy query says %d workgroups per CU\n", per_cu); }
        (void)hipGetLastError();
        grid = cus;
    }
    if (grid < 0) return;
    if (hipMemsetAsync((char*)d_ws + WS_CTL, 0, CTL_ZERO_BYTES, stream) != hipSuccess) return;
    Args a{};
    for (int i = 0; i < 15; ++i) a.in[i] = (const float*)d_in[i];
    a.out = (float*)d_out; a.ws = (unsigned char*)d_ws;
    if (MK_N_LAUNCHES == 1) { a.ph_lo = 0; a.ph_hi = N_PHASES; hipLaunchKernelGGL(fwd_kernel, dim3(grid), dim3(512), LDS_BYTES, stream, a); }
    else for (int p = 0; p < N_PHASES; ++p) { a.ph_lo = p; a.ph_hi = p + 1; hipLaunchKernelGGL(fwd_kernel, dim3(grid), dim3(512), LDS_BYTES, stream, a); }
}
#endif
```
